# Optimizing an MI355X kernel written in HIP

```python
import math
import jax, jax.numpy as jnp
from jax import lax
import numpy as np

D_MODEL = 2048
BATCH = 1
SEQ = 8192
DEPTH = 4

N_A_LAYERS = DEPTH // 2
N_B_LAYERS = DEPTH - N_A_LAYERS

NSA_HEADS = 16
NSA_KV_HEADS = 4
NSA_GROUP = NSA_HEADS // NSA_KV_HEADS
NSA_HEAD_DIM = D_MODEL // NSA_HEADS
CMP_BLOCK = 32
CMP_STRIDE = 16
CMP_HIDDEN = 4 * NSA_HEAD_DIM
SEL_BLOCK = 64
SEL_TOPK = 16
WINDOW = 512
FORCE_SCORE = 1.0e4
NSA_IN_COLS = NSA_HEADS * NSA_HEAD_DIM + 6 * NSA_KV_HEADS * NSA_HEAD_DIM + 3 * NSA_HEADS

DIFF_HEADS = 16
DIFF_KV_HEADS = 4
DIFF_GROUP = DIFF_HEADS // DIFF_KV_HEADS
DIFF_HEAD_DIM = D_MODEL // (2 * DIFF_HEADS)
DIFF_KV_COLS = DIFF_KV_HEADS * 2 * DIFF_HEAD_DIM * 2

D_FF = 4 * D_MODEL

ROPE_THETA = 500000.0
ROPE_FRACTION = 4
Q_BLOCK = 128
NORM_EPS = 1e-6

kernel_name = "yoco_nsa_diffattn_hybrid"


def rms_norm(x, g):
    xf = x.astype(jnp.float32)
    y = xf * lax.rsqrt(jnp.mean(xf * xf, axis=-1, keepdims=True) + NORM_EPS)
    return (y * g.astype(jnp.float32)).astype(x.dtype)


def rope_tables(seq, head_dim):
    rot = head_dim // ROPE_FRACTION
    inv = 1.0 / (ROPE_THETA ** (jnp.arange(0, rot, 2, dtype=jnp.float32) / rot))
    ang = jnp.arange(seq, dtype=jnp.float32)[:, None] * inv[None, :]
    return jnp.cos(ang), jnp.sin(ang)


def apply_partial_rope(x, cos, sin):
    half = cos.shape[-1]
    x1, x2, xp = x[..., :half], x[..., half:2 * half], x[..., 2 * half:]
    c, s = cos.astype(x.dtype), sin.astype(x.dtype)
    return jnp.concatenate([x1 * c - x2 * s, x1 * s + x2 * c, xp], axis=-1)


def masked_softmax(s, valid):
    s = jnp.where(valid, s.astype(jnp.float32), -jnp.inf)
    m = jnp.max(s, axis=-1, keepdims=True)
    m = jnp.where(jnp.isfinite(m), m, 0.0)
    e = jnp.exp(s - m)
    den = jnp.sum(e, axis=-1, keepdims=True)
    return e / jnp.maximum(den, 1e-30)


def sq_relu_mlp(h, w_up, w_down):
    return jnp.square(jax.nn.relu(h @ w_up)) @ w_down


def nsa_mixer(h, w_in, cmp_pos, cmp_w1, cmp_w2, w_out, cos, sin):
    B, S, _ = h.shape
    H, Hk, G, dk = NSA_HEADS, NSA_KV_HEADS, NSA_GROUP, NSA_HEAD_DIM
    kvw = Hk * dk
    scale = dk ** -0.5
    proj = h @ w_in
    q = proj[..., :H * dk].reshape(B, S, Hk, G, dk).transpose(0, 2, 3, 1, 4)
    parts = [proj[..., H * dk + i * kvw:H * dk + (i + 1) * kvw]
             .reshape(B, S, Hk, dk).transpose(0, 2, 1, 3) for i in range(6)]
    k_c, v_c, k_s, v_s, k_w, v_w = parts
    gates = jax.nn.sigmoid(proj[..., H * dk + 6 * kvw:].astype(jnp.float32))
    gates = gates.reshape(B, S, Hk, G, 3).transpose(0, 2, 3, 1, 4)

    n_cmp = (S - CMP_BLOCK) // CMP_STRIDE + 1
    idx = jnp.arange(n_cmp)[:, None] * CMP_STRIDE + jnp.arange(CMP_BLOCK)[None, :]

    def compress(t, j):
        blk = (t[:, :, idx] + cmp_pos[j]).reshape(B, Hk, n_cmp, CMP_BLOCK * dk)
        return jax.nn.gelu(blk @ cmp_w1[j]) @ cmp_w2[j]

    kc, vc = compress(k_c, 0), compress(v_c, 1)
    cmp_end = idx[:, -1]

    n_sel = S // SEL_BLOCK
    topk = min(SEL_TOPK, n_sel)
    cs = jnp.arange(n_cmp) * CMP_STRIDE
    ss = jnp.arange(n_sel) * SEL_BLOCK
    overlap = ((cs[:, None] < ss[None, :] + SEL_BLOCK) &
               (cs[:, None] + CMP_BLOCK > ss[None, :])).astype(jnp.float32)

    q_rot = apply_partial_rope(q, cos, sin)
    ks_blocks = apply_partial_rope(k_s, cos, sin).reshape(B, Hk, n_sel, SEL_BLOCK, dk)
    vs_blocks = v_s.reshape(B, Hk, n_sel, SEL_BLOCK, dk)
    pad = ((0, 0), (0, 0), (WINDOW, 0), (0, 0))
    kw_pad = jnp.pad(apply_partial_rope(k_w, cos, sin), pad)
    vw_pad = jnp.pad(v_w, pad)
    gather = jax.vmap(jax.vmap(lambda blocks, ix: blocks[ix]))
    sel_ids = jnp.arange(n_sel)

    def block_fn(qb):
        start = qb * Q_BLOCK
        t = start + jnp.arange(Q_BLOCK)
        qr = lax.dynamic_slice_in_dim(q, start, Q_BLOCK, axis=3)
        qo = lax.dynamic_slice_in_dim(q_rot, start, Q_BLOCK, axis=3)
        g = lax.dynamic_slice_in_dim(gates, start, Q_BLOCK, axis=3)

        s_c = jnp.einsum('bhgqd,bhnd->bhgqn', qr, kc) * scale
        p_c = masked_softmax(s_c, cmp_end[None, :] <= t[:, None])
        o_c = jnp.einsum('bhgqn,bhnd->bhgqd', p_c.astype(vc.dtype), vc)

        imp = jnp.einsum('bhgqn,ns->bhqs', p_c, overlap)
        cur = t // SEL_BLOCK
        forced = ((sel_ids[None, :] == 0) | (sel_ids[None, :] == cur[:, None]) |
                  (sel_ids[None, :] == cur[:, None] - 1))
        imp = jnp.where(forced, FORCE_SCORE, imp)
        imp = jnp.where(ss[None, :] <= t[:, None], imp, -1.0)
        _, sel_idx = lax.top_k(imp, topk)
        k_g = gather(ks_blocks, sel_idx).reshape(B, Hk, Q_BLOCK, topk * SEL_BLOCK, dk)
        v_g = gather(vs_blocks, sel_idx).reshape(B, Hk, Q_BLOCK, topk * SEL_BLOCK, dk)
        key_pos = sel_idx[..., None] * SEL_BLOCK + jnp.arange(SEL_BLOCK)
        valid_s = (key_pos <= t[:, None, None]).reshape(B, Hk, 1, Q_BLOCK, topk * SEL_BLOCK)
        s_s = jnp.einsum('bhgqd,bhqkd->bhgqk', qo, k_g) * scale
        p_s = masked_softmax(s_s, valid_s)
        o_s = jnp.einsum('bhgqk,bhqkd->bhgqd', p_s.astype(v_g.dtype), v_g)

        kw = lax.dynamic_slice_in_dim(kw_pad, start, Q_BLOCK + WINDOW, axis=2)
        vw = lax.dynamic_slice_in_dim(vw_pad, start, Q_BLOCK + WINDOW, axis=2)
        kpos = start - WINDOW + jnp.arange(Q_BLOCK + WINDOW)
        valid_w = ((kpos[None, :] <= t[:, None]) & (kpos[None, :] > t[:, None] - WINDOW) &
                   (kpos[None, :] >= 0))
        s_w = jnp.einsum('bhgqd,bhkd->bhgqk', qo, kw) * scale
        p_w = masked_softmax(s_w, valid_w)
        o_w = jnp.einsum('bhgqk,bhkd->bhgqd', p_w.astype(vw.dtype), vw)

        gg = g.astype(o_c.dtype)
        return gg[..., 0:1] * o_c + gg[..., 1:2] * o_s + gg[..., 2:3] * o_w

    o = lax.map(block_fn, jnp.arange(S // Q_BLOCK))
    o = o.transpose(1, 0, 4, 2, 3, 5).reshape(B, S, H * dk)
    return o @ w_out


def shared_kv(x, g, w_kv, cos, sin):
    B, S, _ = x.shape
    Hk, d = DIFF_KV_HEADS, DIFF_HEAD_DIM
    kv = rms_norm(x, g) @ w_kv
    kcols = Hk * 2 * d
    k = kv[..., :kcols].reshape(B, S, Hk, 2, d).transpose(0, 2, 3, 1, 4)
    k = apply_partial_rope(k, cos, sin)
    v = kv[..., kcols:].reshape(B, S, Hk, 2 * d).transpose(0, 2, 1, 3)
    return k, v


def diff_mixer(h, w_q, lam_vecs, subln_g, w_out, k_sh, v_sh, cos, sin, lambda_init):
    B, S, _ = h.shape
    H, Hk, G, d = DIFF_HEADS, DIFF_KV_HEADS, DIFF_GROUP, DIFF_HEAD_DIM
    scale = d ** -0.5
    q = (h @ w_q).reshape(B, S, Hk, G, 2, d).transpose(0, 2, 3, 4, 1, 5)
    q = apply_partial_rope(q, cos, sin)
    lv = lam_vecs.astype(jnp.float32)
    lam = jnp.exp(jnp.sum(lv[0] * lv[1])) - jnp.exp(jnp.sum(lv[2] * lv[3])) + lambda_init
    kpos = jnp.arange(S)

    def block_fn(qb):
        start = qb * Q_BLOCK
        t = start + jnp.arange(Q_BLOCK)
        qblk = lax.dynamic_slice_in_dim(q, start, Q_BLOCK, axis=4)
        s = jnp.einsum('bhgcqd,bhckd->bhgcqk', qblk, k_sh) * scale
        p = masked_softmax(s, kpos[None, :] <= t[:, None])
        a = p[:, :, :, 0] - lam * p[:, :, :, 1]
        return jnp.einsum('bhgqk,bhkd->bhgqd', a.astype(v_sh.dtype), v_sh)

    o = lax.map(block_fn, jnp.arange(S // Q_BLOCK))
    o = o.transpose(1, 0, 4, 2, 3, 5).reshape(B, S, H, 2 * d)
    o = rms_norm(o, subln_g) * (1.0 - lambda_init)
    return o.reshape(B, S, H * 2 * d) @ w_out


def setup_inputs(seed: int = 0) -> dict:
    key = jax.random.key(seed)
    ks = jax.random.split(key, 20)
    f32 = jnp.float32
    nrm = lambda k, shape, s: jax.random.normal(k, shape, f32) * s
    dk, d = NSA_HEAD_DIM, DIFF_HEAD_DIM
    return {
        "x": nrm(ks[0], (BATCH, SEQ, D_MODEL), 1.0),
        "attn_norm_g": 1.0 + nrm(ks[1], (DEPTH, D_MODEL), 0.02),
        "mlp_norm_g": 1.0 + nrm(ks[2], (DEPTH, D_MODEL), 0.02),
        "final_norm_g": 1.0 + nrm(ks[3], (D_MODEL,), 0.02),
        "nsa_w_in": nrm(ks[4], (N_A_LAYERS, D_MODEL, NSA_IN_COLS), D_MODEL ** -0.5),
        "nsa_cmp_pos": nrm(ks[5], (N_A_LAYERS, 2, CMP_BLOCK, dk), 0.1),
        "nsa_cmp_w1": nrm(ks[6], (N_A_LAYERS, 2, CMP_BLOCK * dk, CMP_HIDDEN), (CMP_BLOCK * dk) ** -0.5),
        "nsa_cmp_w2": nrm(ks[7], (N_A_LAYERS, 2, CMP_HIDDEN, dk), CMP_HIDDEN ** -0.5),
        "nsa_w_out": nrm(ks[8], (N_A_LAYERS, D_MODEL, D_MODEL), D_MODEL ** -0.5),
        "kv_norm_g": 1.0 + nrm(ks[9], (D_MODEL,), 0.02),
        "kv_w_shared": nrm(ks[10], (D_MODEL, DIFF_KV_COLS), D_MODEL ** -0.5),
        "diff_w_q": nrm(ks[11], (N_B_LAYERS, D_MODEL, 2 * DIFF_HEADS * d), D_MODEL ** -0.5),
        "diff_lambda": nrm(ks[12], (N_B_LAYERS, 4, d), 0.1),
        "diff_subln_g": 1.0 + nrm(ks[13], (N_B_LAYERS, 2 * d), 0.02),
        "diff_w_out": nrm(ks[14], (N_B_LAYERS, DIFF_HEADS * 2 * d, D_MODEL), D_MODEL ** -0.5),
        "mlp_w_up": nrm(ks[15], (DEPTH, D_MODEL, D_FF), D_MODEL ** -0.5),
        "mlp_w_down": nrm(ks[16], (DEPTH, D_FF, D_MODEL), D_FF ** -0.5),
    }


def reference(x, attn_norm_g, mlp_norm_g, final_norm_g, nsa_w_in, nsa_cmp_pos, nsa_cmp_w1,
              nsa_cmp_w2, nsa_w_out, kv_norm_g, kv_w_shared, diff_w_q, diff_lambda,
              diff_subln_g, diff_w_out, mlp_w_up, mlp_w_down):
    S = x.shape[1]
    cos_a, sin_a = rope_tables(S, NSA_HEAD_DIM)
    cos_b, sin_b = rope_tables(S, DIFF_HEAD_DIM)
    k_sh, v_sh = None, None
    for layer in range(DEPTH):
        h = rms_norm(x, attn_norm_g[layer])
        if layer < N_A_LAYERS:
            x = x + nsa_mixer(h, nsa_w_in[layer], nsa_cmp_pos[layer], nsa_cmp_w1[layer],
                              nsa_cmp_w2[layer], nsa_w_out[layer], cos_a, sin_a)
        else:
            j = layer - N_A_LAYERS
            if j == 0:
                k_sh, v_sh = shared_kv(x, kv_norm_g, kv_w_shared, cos_b, sin_b)
            lambda_init = 0.8 - 0.6 * math.exp(-0.3 * layer)
            x = x + diff_mixer(h, diff_w_q[j], diff_lambda[j], diff_subln_g[j], diff_w_out[j],
                               k_sh, v_sh, cos_b, sin_b, lambda_init)
        x = x + sq_relu_mlp(rms_norm(x, mlp_norm_g[layer]), mlp_w_up[layer], mlp_w_down[layer])
    return rms_norm(x, final_norm_g)
```

```cpp
#include <hip/hip_runtime.h>
#include <hip/hip_bf16.h>
#include <hip/hip_cooperative_groups.h>
#include <cstdio>
#include <cstdint>
namespace cg = cooperative_groups;
#ifndef PROBE
#define PROBE 0
#endif
__device__ __forceinline__ int mktid(int wave_s) { int t; asm volatile("v_mbcnt_lo_u32_b32 %0, -1, 0\n\tv_mbcnt_hi_u32_b32 %0, -1, %0\n\tv_lshl_or_b32 %0, %1, 6, %0" : "=&v"(t) : "s"(wave_s)); return t; }
__device__ __forceinline__ float ozero() { float z; asm volatile("v_mov_b32 %0, 0" : "=v"(z)); return z; }
__device__ __forceinline__ int lbid() { int b = blockIdx.x; asm volatile("" : "+s"(b)); return b; }
__device__ __forceinline__ int lgrid() { int g = gridDim.x; asm volatile("" : "+s"(g)); return g; }
namespace pg8 {
#define PG8_LAS __attribute__((address_space(3)))
typedef unsigned short bf16_t;
typedef short bf16x8 __attribute__((ext_vector_type(8)));
typedef float f32x4 __attribute__((ext_vector_type(4)));
typedef unsigned u32x4 __attribute__((ext_vector_type(4)));
constexpr int BM = 256, BK = 64, HALF = 128, HTB = HALF * BK * 2  , STAGE_BYTES = 8 * HTB, NXCD = 8, WGM = 8;

__host__ __device__ __forceinline__ int lds_byte(int r, int c) { const int st = (r >> 4) * 2 + (c >> 5), rr = r & 15, cc = c & 31, ob = rr * 64 + cc * 2; return st * 1024 + (ob ^ (((ob >> 9) & 1) << 5)); }
__host__ __device__ __forceinline__ void stage_rc(int b, int& R, int& C) { const int st = b / 1024, sb = b % 1024, swz = sb ^ (((sb >> 9) & 1) << 5); R = (st >> 1) * 16 + swz / 64; C = (st & 1) * 32 + (swz % 64) / 2; }
__host__ __device__ __forceinline__ int perm32(int rho) { const int n = rho >> 4, i = rho & 15; return 8 * (i >> 2) + 4 * n + (i & 3); }

struct Unit { int pm, pn, pz; };
struct Gemm { const bf16_t* A; const bf16_t* Bt; int M, N, K, lda, ldb; };

struct StaticOrder {
    int nM, nN, nwg, G, c;
    __host__ __device__ void init(int M, int N, int G_, int c_) { nM = M / BM; nN = N / BM; nwg = nM * nN; G = G_; c = c_; }
    __host__ __device__ bool next(int i, Unit& u) const {
        const long L = (long)i * G + c; if (L >= nwg) return false;
        int wgid = (int)L; { const int q = nwg / NXCD, r = nwg % NXCD, xcd = wgid % NXCD, off = wgid / NXCD; wgid = (xcd < r ? xcd * (q + 1) : r * (q + 1) + (xcd - r) * q) + off; }
        const int nig = WGM * nN, gid = wgid / nig, fm = gid * WGM, gsz = (nM - fm) < WGM ? (nM - fm) : WGM;
        u.pm = fm + ((wgid % nig) % gsz); u.pn = (wgid % nig) / gsz; u.pz = i; return true;
    }
    __device__ __forceinline__ void a_ready(const Unit&) const {}
    __device__ __forceinline__ void done(const Unit&) const {}
    __device__ __forceinline__ size_t aoff(const Unit&) const { return 0; }
    __device__ __forceinline__ size_t boff(const Unit&) const { return 0; }
};

__device__ __forceinline__ unsigned cvt_pk_bf16(float lo, float hi) { unsigned r; asm volatile("v_cvt_pk_bf16_f32 %0, %1, %2" : "=v"(r) : "v"(lo), "v"(hi)); return r; }

template <class Epi, class Sched, bool ALIGN_EPI = false, bool SP2 = false>
__device__ __forceinline__ void gemm_phase(PG8_LAS unsigned char* lds, const Gemm g, const Sched& S, const Epi& E, const int tid) {
    const int wid = __builtin_amdgcn_readfirstlane(tid >> 6), lane = tid & 63, wr = wid >> 2, wc = wid & 3, fr = lane & 15, fq = lane >> 4;
    const int K = g.K, nt = K / BK;
    unsigned voffA[2], voffB[2];
#pragma unroll
    for (int i = 0; i < 2; ++i) { int R, C; stage_rc(tid * 16 + i * 8192, R, C); const int Rb = Epi::PERM ? ((R & ~31) + perm32(R & 31)) : R;
        voffA[i] = (unsigned)(R * g.lda + C) * 2u; voffB[i] = (unsigned)(Rb * g.ldb + C) * 2u; }
    const size_t kstep = (size_t)(BK * 2);
    const size_t hstepA = (size_t)HALF * g.lda * 2, hstepB = (size_t)HALF * g.ldb * 2;
    const size_t tstepA = 2 * hstepA, tstepB = 2 * hstepB;
    const unsigned ldsw = (unsigned)wid * 1024u;
    const int aoff = lds_byte(wr * 64 + fr, fq * 8), boff = lds_byte(wc * 32 + fr, fq * 8);
#define PG8_SA(b, h) (((b) * 2 + (h)) * HTB)
#define PG8_SB(b, h) ((4 + (b) * 2 + (h)) * HTB)
#define PG8_STAGE(bufoff, gbase, voff) do { _Pragma("unroll") for (int _i = 0; _i < 2; ++_i) \
        __builtin_amdgcn_global_load_lds((const unsigned*)((const char*)(gbase) + (voff)[_i]), (PG8_LAS unsigned*)(lds + (bufoff) + ldsw + _i * 8192), 16, 0, 0); } while (0)
#define PG8_LDA(dst, b, h) do { _Pragma("unroll") for (int m = 0; m < 4; ++m) _Pragma("unroll") for (int k = 0; k < 2; ++k) dst[m][k] = *(const PG8_LAS bf16x8*)(lds + PG8_SA(b, h) + aoff + m * 2048 + k * 1024); } while (0)
#define PG8_LDB(dst, b, h) do { _Pragma("unroll") for (int n = 0; n < 2; ++n) _Pragma("unroll") for (int k = 0; k < 2; ++k) dst[n][k] = *(const PG8_LAS bf16x8*)(lds + PG8_SB(b, h) + boff + n * 2048 + k * 1024); } while (0)
#define PG8_MMA(ai, bj, At, Bt) do { __builtin_amdgcn_s_setprio(1); _Pragma("unroll") for (int m = 0; m < 4; ++m) _Pragma("unroll") for (int n = 0; n < 2; ++n) _Pragma("unroll") for (int k = 0; k < 2; ++k) \
        acc[ai][bj][m][n] = __builtin_amdgcn_mfma_f32_16x16x32_bf16(Bt[n][k], At[m][k], acc[ai][bj][m][n], 0, 0, 0); __builtin_amdgcn_s_setprio(0); } while (0)
#define PG8_WAIT_V(n) asm volatile("s_waitcnt vmcnt(" #n ")" ::: "memory")
#define PG8_WAIT_L(n) asm volatile("s_waitcnt lgkmcnt(" #n ")" ::: "memory")
#define PG8_BAR __builtin_amdgcn_s_barrier()
#define PG8_SCHED __builtin_amdgcn_sched_barrier(0)
    Unit cur, nxt; int ui = 0; const float zf_ = ozero();
    if (!S.next(0, cur)) return;
    f32x4 acc[2][2][4][2];
#pragma unroll
    for (int a = 0; a < 2; ++a)
#pragma unroll
        for (int b = 0; b < 2; ++b)
#pragma unroll
            for (int m = 0; m < 4; ++m)
#pragma unroll
                for (int n = 0; n < 2; ++n) acc[a][b][m][n] = (f32x4){zf_, zf_, zf_, zf_};
    bf16x8 At[4][2], B0[2][2], B1[2][2];
    const char* cA = (const char*)g.A + (size_t)cur.pm * tstepA + S.aoff(cur); const char* cB = (const char*)g.Bt + (size_t)cur.pn * tstepB + S.boff(cur);
    S.a_ready(cur);
    if constexpr (SP2) {
        PG8_STAGE(PG8_SB(0, 0), cB, voffB); PG8_STAGE(PG8_SB(0, 1), cB + hstepB, voffB); PG8_STAGE(PG8_SA(0, 0), cA, voffA); PG8_STAGE(PG8_SA(0, 1), cA + hstepA, voffA);
        if (wr == 1) PG8_BAR;
        PG8_WAIT_V(2); PG8_BAR;
        PG8_STAGE(PG8_SB(1, 0), cB + kstep, voffB); PG8_STAGE(PG8_SA(1, 0), cA + kstep, voffA); PG8_STAGE(PG8_SB(1, 1), cB + hstepB + kstep, voffB);
        PG8_WAIT_V(6); PG8_BAR;
    } else {
        PG8_STAGE(PG8_SB(0, 0), cB, voffB); PG8_STAGE(PG8_SA(0, 0), cA, voffA); PG8_STAGE(PG8_SB(0, 1), cB + hstepB, voffB); PG8_STAGE(PG8_SA(0, 1), cA + hstepA, voffA);
        if (wr == 1) PG8_BAR;
        PG8_WAIT_V(4); PG8_BAR;
        PG8_STAGE(PG8_SB(1, 0), cB + kstep, voffB); PG8_STAGE(PG8_SA(1, 0), cA + kstep, voffA); PG8_STAGE(PG8_SB(1, 1), cB + hstepB + kstep, voffB);
        PG8_WAIT_V(6); PG8_BAR;
    }
    for (;;) {
        const bool has_next = S.next(ui + 1, nxt);
        const char* nA = has_next ? (const char*)g.A + (size_t)nxt.pm * tstepA + S.aoff(nxt) : cA; const char* nB = has_next ? (const char*)g.Bt + (size_t)nxt.pn * tstepB + S.boff(nxt) : cB;
        for (int t = 0; t < nt; t += 2) {
            const bool last = (t == nt - 2);
            const char* a1 = cA + (size_t)(t + 1) * kstep;
            const char* a2 = last ? nA : cA + (size_t)(t + 2) * kstep; const char* b2 = last ? nB : cB + (size_t)(t + 2) * kstep;
            const char* a3 = a2 + kstep; const char* b3 = b2 + kstep;
            if (last && has_next) S.a_ready(nxt);
            if constexpr (SP2) {
            PG8_LDB(B0, 0, 0); PG8_LDB(B1, 0, 1); PG8_SCHED; PG8_LDA(At, 0, 0); PG8_STAGE(PG8_SA(1, 1), a1 + hstepA, voffA);
            PG8_WAIT_V(8); PG8_WAIT_L(0); PG8_BAR; PG8_MMA(0, 0, At, B0); PG8_MMA(0, 1, At, B1); PG8_BAR; PG8_SCHED;
            PG8_LDA(At, 0, 1); PG8_STAGE(PG8_SB(0, 0), b2, voffB); PG8_STAGE(PG8_SB(0, 1), b2 + hstepB, voffB); PG8_STAGE(PG8_SA(0, 0), a2, voffA);
            PG8_WAIT_V(8); PG8_WAIT_L(0); PG8_BAR; PG8_MMA(1, 0, At, B0); PG8_MMA(1, 1, At, B1); PG8_BAR; PG8_SCHED;
            PG8_LDB(B0, 1, 0); PG8_LDB(B1, 1, 1); PG8_SCHED; PG8_LDA(At, 1, 0); PG8_STAGE(PG8_SA(0, 1), a2 + hstepA, voffA);
            PG8_WAIT_V(8); PG8_WAIT_L(0); PG8_BAR; PG8_MMA(0, 0, At, B0); PG8_MMA(0, 1, At, B1); PG8_BAR; PG8_SCHED;
            PG8_LDA(At, 1, 1); PG8_STAGE(PG8_SB(1, 0), b3, voffB); PG8_STAGE(PG8_SB(1, 1), b3 + hstepB, voffB); PG8_STAGE(PG8_SA(1, 0), a3, voffA);
            PG8_WAIT_V(8); PG8_WAIT_L(0); PG8_BAR; PG8_MMA(1, 0, At, B0); PG8_MMA(1, 1, At, B1); PG8_BAR; PG8_SCHED;
            } else {
            PG8_LDB(B0, 0, 0); PG8_SCHED; PG8_LDA(At, 0, 0); PG8_STAGE(PG8_SA(1, 1), a1 + hstepA, voffA);
            PG8_WAIT_L(8); PG8_BAR; PG8_WAIT_L(0); PG8_MMA(0, 0, At, B0); PG8_BAR; PG8_SCHED;
            PG8_LDB(B1, 0, 1); PG8_STAGE(PG8_SB(0, 0), b2, voffB);
            PG8_BAR; PG8_WAIT_L(0); PG8_MMA(0, 1, At, B1); PG8_BAR;
            PG8_LDA(At, 0, 1); PG8_STAGE(PG8_SA(0, 0), a2, voffA);
            PG8_BAR; PG8_WAIT_L(0); PG8_MMA(1, 0, At, B0); PG8_BAR; PG8_SCHED;
            PG8_STAGE(PG8_SB(0, 1), b2 + hstepB, voffB);
            PG8_WAIT_V(6); PG8_BAR; PG8_MMA(1, 1, At, B1); PG8_BAR;
            PG8_LDB(B0, 1, 0); PG8_SCHED; PG8_LDA(At, 1, 0); PG8_STAGE(PG8_SA(0, 1), a2 + hstepA, voffA);
            PG8_WAIT_L(8); PG8_BAR; PG8_WAIT_L(0); PG8_MMA(0, 0, At, B0); PG8_BAR; PG8_SCHED;
            PG8_LDB(B1, 1, 1); PG8_STAGE(PG8_SB(1, 0), b3, voffB);
            PG8_BAR; PG8_WAIT_L(0); PG8_MMA(0, 1, At, B1); PG8_BAR;
            PG8_LDA(At, 1, 1); PG8_STAGE(PG8_SA(1, 0), a3, voffA);
            PG8_BAR; PG8_WAIT_L(0); PG8_MMA(1, 0, At, B0); PG8_BAR; PG8_SCHED;
            PG8_STAGE(PG8_SB(1, 1), b3 + hstepB, voffB);
            PG8_WAIT_V(6); PG8_BAR; PG8_MMA(1, 1, At, B1); PG8_BAR;
            }
        }
        if constexpr (ALIGN_EPI) { if (wr == 0) PG8_BAR; }
        if constexpr (!Epi::AFTER_DRAIN) { E(acc, cur, wr, wc, fr, fq); S.done(cur); }
        if (!has_next) break;
#pragma unroll
        for (int a = 0; a < 2; ++a)
#pragma unroll
            for (int b = 0; b < 2; ++b)
#pragma unroll
                for (int m = 0; m < 4; ++m)
#pragma unroll
                    for (int n = 0; n < 2; ++n) acc[a][b][m][n] = (f32x4){zf_, zf_, zf_, zf_};
        cur = nxt; cA = nA; cB = nB; ++ui;
        if constexpr (ALIGN_EPI) { if (wr == 1) PG8_BAR; }
    }
    PG8_WAIT_V(0);
    if constexpr (!ALIGN_EPI) { if (wr == 0) PG8_BAR; }
    PG8_BAR;
    if constexpr (Epi::AFTER_DRAIN) { E.fused(acc, cur, wr, wc, fr, fq, lds, wid, lane); S.done(cur); }
#undef PG8_SA
#undef PG8_SB
#undef PG8_STAGE
#undef PG8_LDA
#undef PG8_LDB
#undef PG8_MMA
#undef PG8_WAIT_V
#undef PG8_WAIT_L
#undef PG8_BAR
#undef PG8_SCHED
}
}

namespace fa {
constexpr int D = 128; constexpr float THR = 8.f; constexpr bool WSKIP = false;
constexpr float SCALE = 0.08838834764831845f;
constexpr int NW = 8, QBLK = 32, KVBLK = 64, QB = NW * QBLK;
constexpr int SHM_V = KVBLK * D * 2, SHM_K = KVBLK * D * 2;
constexpr int FA_LDS_BYTES = 2 * SHM_V + 2 * SHM_K + NW * 64 * 4;

using bf16 = __hip_bfloat16;
typedef short bf16x8 __attribute__((ext_vector_type(8)));
typedef short s16x4 __attribute__((ext_vector_type(4)));
typedef float f32x16 __attribute__((ext_vector_type(16)));
typedef float f32x4 __attribute__((ext_vector_type(4)));
typedef unsigned u32x4 __attribute__((ext_vector_type(4)));
template <class A, class Bt> struct same_t { static constexpr bool v = false; };
template <class A> struct same_t<A, A> { static constexpr bool v = true; };

#define KSWZ(row, colB) ((row) * 256 + ((colB) ^ (((row) & 7) << 4)))
#define SBAR() __builtin_amdgcn_sched_barrier(0)
__device__ __forceinline__ int v_st(int k, int c) { const int kk = (k & ~0xC) | ((k & 4) << 1) | ((k & 8) >> 1); return ((kk >> 3) * 4 + (c >> 5)) * 512 + ((kk & 7) * 32 + (c & 31)) * 2; }
__device__ __forceinline__ int v_rd_base(int lane) { return ((lane & 3) << 3) | (((lane >> 2) & 3) << 6) | (((lane >> 4) & 1) << 5) | (((lane >> 5) & 1) << 8); }
constexpr int v_rd_off(int d0, int ks, int half) { return d0 * 512 + ks * 4096 + half * 2048; }
__device__ __forceinline__ int crow(int r, int hi) { return (r & 3) + 8 * (r >> 2) + 4 * hi; }
__device__ __forceinline__ unsigned cvtpk(float lo, float hi) {
    unsigned r; asm volatile("v_cvt_pk_bf16_f32 %0, %1, %2" : "=v"(r) : "v"(lo), "v"(hi)); return r;
}
__device__ __forceinline__ bf16x8 pack8(f32x4 a, f32x4 b) {
    u32x4 w = {cvtpk(a[0], a[1]), cvtpk(a[2], a[3]), cvtpk(b[0], b[1]), cvtpk(b[2], b[3])};
    return *reinterpret_cast<bf16x8*>(&w);
}
template <class T> __device__ __forceinline__ bf16x8 load8(const T* p) {
    if constexpr (same_t<T, float>::v) { return pack8(*(const f32x4*)p, *(const f32x4*)(p + 4)); }
    else { return *reinterpret_cast<const bf16x8*>(p); }
}
__device__ __forceinline__ void mask_tile(f32x16& p0, f32x16& p1, int dq, unsigned W) {
    const float NEG = -__builtin_inff();
#pragma unroll
    for (int r = 0; r < 16; ++r) {
        const int c = (r & 3) + 8 * (r >> 2);
        if ((unsigned)(dq - c) >= W) p0[r] = NEG;
        if ((unsigned)(dq - c - 32) >= W) p1[r] = NEG;
    }
}
__device__ __forceinline__ bool rowsel_bit(const u32x4& mw, int T) { const int tw = T >> 5; const unsigned w = tw == 0 ? mw.x : tw == 1 ? mw.y : tw == 2 ? mw.z : mw.w; return ((w >> (T & 31)) & 1u) != 0u; }
__device__ __forceinline__ bool rowsel_upd(unsigned& mwc, const char* lds, int rowidx, int T, bool first) { if ((T & 31) == 0 || first) mwc = ((const unsigned*)(lds + FA_LDS_BYTES))[rowidx * 4 + (T >> 5)]; return ((mwc >> (T & 31)) & 1u) != 0u; }
template <bool HS> __device__ __forceinline__ void partialSM(f32x16& p0, f32x16& p1, float& m_reg, float& mn, float& alpha, bool rs) {
    float pmax = p0[0]; for (int r = 1; r < 16; ++r) pmax = fmaxf(pmax, p0[r]); for (int r = 0; r < 16; ++r) pmax = fmaxf(pmax, p1[r]);
    { auto rr = __builtin_amdgcn_permlane32_swap(__float_as_uint(pmax), __float_as_uint(pmax), false, false);
      pmax = fmaxf(__uint_as_float(rr[0]), __uint_as_float(rr[1])); }
    if (HS && !rs) pmax = -__builtin_inff();
    constexpr float C2 = 1.4426950408889634f * SCALE;
    if (__builtin_expect(__all((pmax - m_reg) * SCALE <= THR), 1)) { mn = m_reg; alpha = 1.f; }
    else { mn = fmaxf(m_reg, pmax); alpha = __builtin_amdgcn_exp2f((m_reg - mn) * C2); m_reg = mn; }
    const float mnL = (HS && !rs) ? -__builtin_inff() : -mn * C2;
    for (int r = 0; r < 16; ++r) p0[r] = fmaf(p0[r], C2, mnL); for (int r = 0; r < 16; ++r) p1[r] = fmaf(p1[r], C2, mnL);
    for (int r = 0; r < 16; ++r) p0[r] = __builtin_amdgcn_exp2f(p0[r]);
}
__device__ __forceinline__ void finishSM(f32x16& p0, f32x16& p1, float alpha, float& l_reg, bf16x8& pa0, bf16x8& pa1, bf16x8& pa2, bf16x8& pa3) {
    for (int r = 0; r < 16; ++r) p1[r] = __builtin_amdgcn_exp2f(p1[r]);
    float ps = 0; for (int r = 0; r < 16; ++r) ps += p0[r]; for (int r = 0; r < 16; ++r) ps += p1[r];
    { auto rr = __builtin_amdgcn_permlane32_swap(__float_as_uint(ps), __float_as_uint(ps), false, false);
      ps = __uint_as_float(rr[0]) + __uint_as_float(rr[1]); }
    l_reg = l_reg * alpha + ps;
#define PK4(P, B_, OUT) do { unsigned a0 = cvtpk(P[B_+0], P[B_+1]), a1 = cvtpk(P[B_+2], P[B_+3]);                          \
        unsigned b0 = cvtpk(P[B_+4], P[B_+5]), b1 = cvtpk(P[B_+6], P[B_+7]);                                             \
        auto r0 = __builtin_amdgcn_permlane32_swap(a0, b0, false, false); auto r1 = __builtin_amdgcn_permlane32_swap(a1, b1, false, false); \
        u32x4 w = {r0[0], r1[0], r0[1], r1[1]}; OUT = *reinterpret_cast<bf16x8*>(&w); } while (0)
    PK4(p0, 0, pa0); PK4(p0, 8, pa1); PK4(p1, 0, pa2); PK4(p1, 8, pa3);
#undef PK4
}
template <int KB, bool SK, int ND = 8>
__device__ __forceinline__ void qkt(f32x16& p0, f32x16& p1, const char* K_lds, int r32, int hi, const bf16x8* qr, bool act) {
    if (SK && !act) { const float NEG = -__builtin_inff();
#pragma unroll
        for (int r = 0; r < 16; ++r) { p0[r] = NEG; p1[r] = NEG; } return; }
    p0 = f32x16{}; p1 = f32x16{};
    const char* kb[4];
#pragma unroll
    for (int dd = 0; dd < 4; ++dd) kb[dd] = K_lds + KB * SHM_K + KSWZ(r32, (dd * 16 + hi * 8) * 2);
#pragma unroll
    for (int d0 = 0; d0 < ND; ++d0) { const char* a = kb[d0 & 3] + (d0 >> 2) * 128;
        bf16x8 b0 = *reinterpret_cast<const bf16x8*>(a);
        bf16x8 b1 = *reinterpret_cast<const bf16x8*>(a + 32 * 256);
        p0 = __builtin_amdgcn_mfma_f32_32x32x16_bf16(b0, qr[d0], p0, 0, 0, 0);
        p1 = __builtin_amdgcn_mfma_f32_32x32x16_bf16(b1, qr[d0], p1, 0, 0, 0); }
}
template <int VB, bool SK>
__device__ __forceinline__ void pv_tile(f32x16* o, int vb0, bf16x8 pa0, bf16x8 pa1, bf16x8 pa2, bf16x8 pa3, bool act) {
    if (SK && !act) return;
#define TRRD(dst, off) asm volatile("ds_read_b64_tr_b16 %0, %1 offset:%2" : "=&v"(dst) : "v"(vb0), "i"(off) : "memory")
#define PV_D0(d0) do { s16x4 l0, l1, l2, l3, h0, h1, h2, h3; constexpr int b_ = VB * SHM_V + v_rd_off(d0, 0, 0);     \
        TRRD(l0, b_); TRRD(h0, b_ + 2048); TRRD(l1, b_ + 4096); TRRD(h1, b_ + 6144); TRRD(l2, b_ + 8192); TRRD(h2, b_ + 10240); TRRD(l3, b_ + 12288); TRRD(h3, b_ + 14336); \
        asm volatile("s_waitcnt lgkmcnt(0)" ::: "memory"); SBAR();                 \
        o[d0] = __builtin_amdgcn_mfma_f32_32x32x16_bf16(pa0, (bf16x8){l0[0], l0[1], l0[2], l0[3], h0[0], h0[1], h0[2], h0[3]}, o[d0], 0, 0, 0);   \
        o[d0] = __builtin_amdgcn_mfma_f32_32x32x16_bf16(pa1, (bf16x8){l1[0], l1[1], l1[2], l1[3], h1[0], h1[1], h1[2], h1[3]}, o[d0], 0, 0, 0);   \
        o[d0] = __builtin_amdgcn_mfma_f32_32x32x16_bf16(pa2, (bf16x8){l2[0], l2[1], l2[2], l2[3], h2[0], h2[1], h2[2], h2[3]}, o[d0], 0, 0, 0);   \
        o[d0] = __builtin_amdgcn_mfma_f32_32x32x16_bf16(pa3, (bf16x8){l3[0], l3[1], l3[2], l3[3], h3[0], h3[1], h3[2], h3[3]}, o[d0], 0, 0, 0); } while (0)
    PV_D0(0); PV_D0(1); PV_D0(2); PV_D0(3);
#undef PV_D0
#undef TRRD
}

template <class TIn, class TOut> struct BlockRef { const TIn* Q; const TIn* K; const TIn* V; TOut* O; int P0, W, jlo, jhi, psub, psh; const u32x4* sel; float2* stats; };
template <class TIn> struct Seam {
    bf16x8 qr[8];
    bf16x8 st_v0, st_v1, st_k0, st_k1; f32x4 sf0, sf1, sf2, sf3;
    f32x4 tq[16];
};
__device__ __forceinline__ int swa_jlo(int P0, int W) { const int lowk = P0 - W + 1; return lowk > 0 ? lowk / KVBLK : 0; }
#define ROW(p, k0, rr) ((p) + (size_t)((k0) + (rr)) * D + sc)
#define VMW() asm volatile("s_waitcnt vmcnt(0)" ::: "memory")
#define VMWN(n) asm volatile("s_waitcnt vmcnt(%0)" :: "i"(n) : "memory")
#define SLOAD_H(Kp, Vp, k0) do { S.st_v0 = load8<TIn>(ROW(Vp, k0, sr)); S.st_v1 = load8<TIn>(ROW(Vp, k0, 32 + sr));              \
                         S.st_k0 = load8<TIn>(ROW(Kp, k0, sr)); S.st_k1 = load8<TIn>(ROW(Kp, k0, 32 + sr)); } while (0)
#define SWRITE_HK(bf) do { *(bf16x8*)(K_lds + (bf) * SHM_K + kws) = S.st_k0; *(bf16x8*)(K_lds + (bf) * SHM_K + kws + 32 * 256) = S.st_k1; } while (0)
#define SWRITE_HV(bf) do { *(bf16x8*)(V_lds + (bf) * SHM_V + vst0) = S.st_v0; *(bf16x8*)(V_lds + (bf) * SHM_V + vst1) = S.st_v1; } while (0)
#define SWRITE_H(bf) do { SWRITE_HV(bf); SWRITE_HK(bf); } while (0)
#define SLOAD_F(p, k0) do { S.sf0 = *(const f32x4*)ROW(p, k0, sr); S.sf1 = *(const f32x4*)(ROW(p, k0, sr) + 4);                \
                            S.sf2 = *(const f32x4*)ROW(p, k0, 32 + sr); S.sf3 = *(const f32x4*)(ROW(p, k0, 32 + sr) + 4); } while (0)
#define SWRITE_KF(bf) do { *(bf16x8*)(K_lds + (bf) * SHM_K + kws) = pack8(S.sf0, S.sf1); *(bf16x8*)(K_lds + (bf) * SHM_K + kws + 32 * 256) = pack8(S.sf2, S.sf3); } while (0)
#define SWRITE_VF(bf) do { *(bf16x8*)(V_lds + (bf) * SHM_V + vst0) = pack8(S.sf0, S.sf1); *(bf16x8*)(V_lds + (bf) * SHM_V + vst1) = pack8(S.sf2, S.sf3); } while (0)
template <class TIn, class TOut>
__device__ __forceinline__ void causal_swa_prime(const BlockRef<TIn, TOut>& cur, char* lds, Seam<TIn>& S, const int tid_in) {
    int tid = tid_in; asm volatile("" : "+v"(tid));
    constexpr bool F32 = same_t<TIn, float>::v;
    const int wid = __builtin_amdgcn_readfirstlane(tid >> 6), lane = tid & 63, r32 = lane & 31, hi = lane >> 5;
    const int sr = tid >> 4, sc = (tid & 15) * 8, kws = KSWZ(sr, sc * 2); char* K_lds = lds + 2 * SHM_V;
    const int kb0 = cur.jlo * KVBLK;
    for (int d0 = 0; d0 < 8; ++d0) S.qr[d0] = load8<TIn>(cur.Q + (size_t)(wid * QBLK + r32) * D + d0 * 16 + hi * 8);
    if constexpr (F32) { SLOAD_F((const float*)cur.K, kb0); VMW(); SWRITE_KF(0); SBAR(); SLOAD_F((const float*)cur.V, kb0); }
    else { SLOAD_H(cur.K, cur.V, kb0); VMW(); SWRITE_HK(0); }
    __syncthreads();
}
template <class TIn, class TOut, bool HS, class NextFn, int ND = 8>
__device__ __forceinline__ void causal_swa_block(const BlockRef<TIn, TOut>& cur, const NextFn& nf, char* lds, Seam<TIn>& S, const int tid_in) {
    int tid = tid_in; asm volatile("" : "+v"(tid));
    constexpr bool F32 = same_t<TIn, float>::v;
    const int wid = __builtin_amdgcn_readfirstlane(tid >> 6), lane = tid & 63, r32 = lane & 31, hi = lane >> 5;
    const int j_lo = cur.jlo, W = cur.W;
    const int j_hi = cur.jhi;
    const int NT = j_hi - j_lo;
    const int qlo = (cur.P0 + wid * QBLK - cur.psub) >> cur.psh, qm = ((cur.P0 + wid * QBLK + r32 - cur.psub) >> cur.psh) - 4 * hi;
    if (HS) { if (hi == 0) *(u32x4*)(lds + FA_LDS_BYTES + (wid * QBLK + r32) * 16) = cur.sel[wid * QBLK + r32]; }
    unsigned mwc = 0u;
#define ROWSEL(t) (HS ? rowsel_upd(mwc, lds, wid * QBLK + r32, j_lo + (t), (t) == 0) : true)
    char* V_lds = lds; char* K_lds = lds + 2 * SHM_V;
    float* ws = (float*)(lds + 2 * SHM_V + 2 * SHM_K) + wid * 64; float* li_l = ws, * al_l = ws + 32;
    float m_reg = -1e30f, l_reg = 0; f32x16 o[4] = {};
    const int sr = tid >> 4, sc = (tid & 15) * 8, vst0 = v_st(sr, sc), vst1 = v_st(32 + sr, sc), kws = KSWZ(sr, sc * 2);
    const int vb0 = (int)(uintptr_t)V_lds + v_rd_base(lane);
    const TIn* Kh = cur.K; const TIn* Vh = cur.V;
#define RESC(a) do { if (__any((a) < 1.f)) { if (hi == 0) al_l[r32] = (a); asm volatile("s_waitcnt lgkmcnt(0)" ::: "memory");              \
                     for (int d_ = 0; d_ < 4; ++d_) for (int r = 0; r < 16; ++r) o[d_][r] *= al_l[crow(r, hi)]; } } while (0)
#define KBASE(t) ((j_lo + (t)) * KVBLK)
#define ACT(t) (KBASE(t) <= qlo + QBLK - 1 && KBASE(t) + KVBLK - 1 >= qlo - W + 1)
#define MASKT(P0_, P1_, t) do { const int kb_ = KBASE(t); if ((!SK || ACT(t)) && (kb_ + KVBLK - 1 > qlo || kb_ <= qlo + QBLK - 1 - W)) mask_tile(P0_, P1_, qm - kb_, (unsigned)W); } while (0)
    constexpr int NQL = F32 ? 16 : 8;
    constexpr bool SK = WSKIP && !F32;
#define SEAM_K0() do { VMWN(NQL); if constexpr (F32) { SWRITE_KF(0); SBAR(); SLOAD_F((const float*)nxt.V, kbn); } else { SWRITE_HK(0); } SBAR(); } while (0)
    f32x16 pA0, pA1, pB0, pB1; float mnA, mnB, alA, alB; bf16x8 pa0, pa1, pa2, pa3;
    if constexpr (F32) { VMW(); SWRITE_VF(0); SBAR(); } else { SWRITE_HV(0); SBAR(); }
    if (NT > 1) { if constexpr (F32) SLOAD_F((const float*)Kh, KBASE(1)); else SLOAD_H(Kh, Vh, KBASE(1)); }
    SBAR(); qkt<0, SK, ND>(pA0, pA1, K_lds, r32, hi, S.qr, ACT(0));
    if constexpr (F32) { if (NT > 1) { VMW(); SWRITE_KF(1); SBAR(); SLOAD_F((const float*)Vh, KBASE(1)); } }
    MASKT(pA0, pA1, 0); partialSM<HS>(pA0, pA1, m_reg, mnA, alA, ROWSEL(0));
    if (NT > 1) { VMW(); if constexpr (F32) { SWRITE_VF(1); SBAR(); if (NT > 2) SLOAD_F((const float*)Kh, KBASE(2)); } else SWRITE_H(1); }
    __syncthreads();
#define HALF_STEP(PX0, PX1, mnX, alX, PY0, PY1, alY, t, KB, VB, SB) do {                                                      \
        SBAR(); qkt<KB, SK, ND>(PX0, PX1, K_lds, r32, hi, S.qr, ACT(t));                                             \
        finishSM(PY0, PY1, alY, l_reg, pa0, pa1, pa2, pa3); SBAR();                                                           \
        if ((t) + 1 < NT) { if constexpr (F32) { VMW(); SWRITE_KF(SB); SBAR(); SLOAD_F((const float*)Vh, KBASE((t) + 1)); }  \
                            else { SLOAD_H(Kh, Vh, KBASE((t) + 1)); } SBAR(); }                                               \
        pv_tile<VB, SK>(o, vb0, pa0, pa1, pa2, pa3, ACT((t) - 1)); MASKT(PX0, PX1, (t)); partialSM<HS>(PX0, PX1, m_reg, mnX, alX, ROWSEL(t));                                        \
        __syncthreads();                                                                                                      \
        if ((t) + 1 < NT) { VMW(); if constexpr (F32) { SWRITE_VF(SB); SBAR(); if ((t) + 2 < NT) SLOAD_F((const float*)Kh, KBASE((t) + 2)); } \
                            else { SWRITE_H(SB); } }                                                                          \
        RESC(alX); __syncthreads(); } while (0)
    for (int t = 1; t + 1 < NT; t += 2) {
        HALF_STEP(pB0, pB1, mnB, alB, pA0, pA1, alA, t, 1, 0, 0);
        HALF_STEP(pA0, pA1, mnA, alA, pB0, pB1, alB, t + 1, 0, 1, 1);
    }
    const bool even = (NT & 1) == 0;
    if (even) { SBAR(); qkt<1, SK, ND>(pB0, pB1, K_lds, r32, hi, S.qr, ACT(NT - 1)); SBAR(); }
    const BlockRef<TIn, TOut> nxt = nf(cur); const int kbn = nxt.jlo * KVBLK;
#define QROW(e) (nxt.Q + (size_t)(wid * QBLK + r32) * D + ((e) >> 1) * 16 + hi * 8 + ((e) & 1) * 4)
    if constexpr (F32) { SLOAD_F((const float*)nxt.K, kbn); SBAR();
#pragma unroll
        for (int e = 0; e < 8; ++e) S.tq[e] = *(const f32x4*)QROW(e); }
    else { SLOAD_H(nxt.K, nxt.V, kbn); SBAR();
#pragma unroll
        for (int d0 = 0; d0 < 8; ++d0) S.qr[d0] = load8<TIn>(nxt.Q + (size_t)(wid * QBLK + r32) * D + d0 * 16 + hi * 8); }
    SBAR();
    finishSM(pA0, pA1, alA, l_reg, pa0, pa1, pa2, pa3); SBAR();
    if constexpr (F32) {
#pragma unroll
        for (int e = 8; e < 16; ++e) S.tq[e] = *(const f32x4*)QROW(e); SBAR(); }
#undef QROW
    pv_tile<0, SK>(o, vb0, pa0, pa1, pa2, pa3, ACT(even ? NT - 2 : NT - 1));
    if (even) { MASKT(pB0, pB1, NT - 1); partialSM<HS>(pB0, pB1, m_reg, mnB, alB, ROWSEL(NT - 1)); __syncthreads(); RESC(alB);
        finishSM(pB0, pB1, alB, l_reg, pa0, pa1, pa2, pa3); SBAR(); pv_tile<1, SK>(o, vb0, pa0, pa1, pa2, pa3, ACT(NT - 1)); }
    SBAR(); SEAM_K0();
    if (hi == 0) li_l[r32] = l_reg; asm volatile("s_waitcnt lgkmcnt(0)" ::: "memory");
    float rli[16];
#pragma unroll
    for (int r = 0; r < 16; ++r) { const float lv_ = li_l[crow(r, hi)]; rli[r] = lv_ > 0.f ? __builtin_amdgcn_rcpf(lv_) : 0.f; }
    if (cur.stats != nullptr && hi == 0) cur.stats[wid * QBLK + r32] = make_float2(m_reg, l_reg);
    TOut* Ow = cur.O + (size_t)(wid * QBLK) * D;
#pragma unroll
    for (int r = 0; r < 16; ++r) { const int orow = crow(r, hi);
#pragma unroll
        for (int d0 = 0; d0 < 4; ++d0) { const float v = o[d0][r] * rli[r];
            if constexpr (same_t<TOut, float>::v) { Ow[(size_t)orow * D + d0 * 32 + r32] = v; }
            else { const float vn = __shfl_xor(v, 1);
                   if ((r32 & 1) == 0) *(unsigned*)(Ow + (size_t)orow * D + d0 * 32 + r32) = cvtpk(v, vn); } } }
    if constexpr (F32) {
#pragma unroll
        for (int d0 = 0; d0 < 8; ++d0) S.qr[d0] = pack8(S.tq[2 * d0], S.tq[2 * d0 + 1]); }
    __syncthreads();
#undef RESC
#undef ROWSEL
#undef KBASE
#undef ACT
#undef MASKT
#undef SEAM_K0
#undef HALF_STEP
}
#undef ROW
#undef VMW
#undef VMWN
#undef SLOAD_H
#undef SWRITE_HK
#undef SWRITE_HV
#undef SWRITE_H
#undef SLOAD_F
#undef SWRITE_KF
#undef SWRITE_VF

}
#define GAS __attribute__((address_space(1)))
#define RLX_AGENT __ATOMIC_RELAXED, __HIP_MEMORY_SCOPE_AGENT
#define LAS __attribute__((address_space(3)))
#define XB_TMO      128
#define XB_XCNT(j)  (256  + 64 * (j))
#define XB_XSUB(j)  (1280 + 64 * (j))
#define XB_XGEN(j)  (2304 + 64 * (j))
#define XB_TOP      3328
#define XB_TOPGEN   3392
#define XCD_BAR_WORDS 3456
#define XB_SPIN_CAP (1u << 18)

__device__ __forceinline__ unsigned xb_ld(unsigned* p)              { return __hip_atomic_load(p, __ATOMIC_RELAXED, __HIP_MEMORY_SCOPE_AGENT); }
__device__ __forceinline__ unsigned xb_add(unsigned* p, unsigned v) { return __hip_atomic_fetch_add(p, v, __ATOMIC_RELAXED, __HIP_MEMORY_SCOPE_AGENT); }
__device__ __forceinline__ unsigned xb_xcc_id() { return (unsigned)__builtin_amdgcn_s_getreg((3 << 11) | 20) & 0xFu; }
#define XB_SPIN(cond, bar) do { unsigned _sp = 0; while (cond) { __builtin_amdgcn_s_sleep(1); \
    if ((++_sp & 255u) == 0u) { if (xb_ld(&(bar)[XB_TMO])) break; if (_sp > XB_SPIN_CAP) { atomicAdd(&(bar)[XB_TMO], 1u); break; } } } } while (0)

struct XcdBarrier {
    unsigned* bar; unsigned x;
    volatile LAS unsigned* st;
};

__device__ __forceinline__ XcdBarrier xcd_barrier_post(unsigned* bar, volatile LAS unsigned* st, const bool t0) {
    XcdBarrier b; b.bar = bar; b.x = xb_xcc_id(); b.st = st;
    if (t0) (void)xb_add(&bar[XB_XCNT(b.x)], 1u);
    return b;
}
__device__ __forceinline__ void xcd_barrier_complete(unsigned* bar, unsigned x, unsigned& nloc, unsigned& nx) {
    const unsigned G = gridDim.x * gridDim.y * gridDim.z;
    unsigned sum, cnt, mine, sp = 0u;
    for (;;) {
        sum = 0u; cnt = 0u; mine = 0u;
#pragma unroll
        for (unsigned j = 0; j < 16; ++j) { const unsigned c = xb_ld(&bar[XB_XCNT(j)]); sum += c; cnt += (c > 0u) ? 1u : 0u; mine = (j == x) ? c : mine; }
        if (sum == G) break;
        __builtin_amdgcn_s_sleep(1);
        if ((++sp & 255u) == 0u) { if (xb_ld(&bar[XB_TMO])) break; if (sp > XB_SPIN_CAP) { atomicAdd(&bar[XB_TMO], 1u); break; } }
    }
    nloc = mine > 0u ? mine : 1u; nx = cnt > 0u ? cnt : 1u;
}

__device__ __forceinline__ void xcd_barrier(const XcdBarrier& b, const bool t0) {
    asm volatile("s_waitcnt vmcnt(0)" ::: "memory");
    __syncthreads();
    if (t0) {
        unsigned* bar = b.bar;
        __builtin_amdgcn_s_waitcnt(0);
        unsigned nloc = b.st[0], nx = b.st[1];
        if (nloc == 0u) { xcd_barrier_complete(bar, b.x, nloc, nx); b.st[0] = nloc; b.st[1] = nx; }
        const unsigned old = xb_add(&bar[XB_XSUB(b.x)], 1u);
        const unsigned gen = old / nloc;
        if (old + 1u == (gen + 1u) * nloc) {
            __builtin_amdgcn_fence(__ATOMIC_RELEASE, "agent");
            asm volatile("s_waitcnt vmcnt(0)" ::: "memory");
            const unsigned og = xb_add(&bar[XB_TOP], 1u);
            const unsigned tg = og / nx;
            if (og + 1u == (tg + 1u) * nx) xb_add(&bar[XB_TOPGEN], 1u);
            else XB_SPIN(xb_ld(&bar[XB_TOPGEN]) == tg, bar);
            __builtin_amdgcn_fence(__ATOMIC_ACQUIRE, "agent");
            xb_add(&bar[XB_XGEN(b.x)], 1u);
            asm volatile("s_waitcnt vmcnt(0)" ::: "memory");
        } else {
            XB_SPIN(xb_ld(&bar[XB_XGEN(b.x)]) == gen, bar);
            __builtin_amdgcn_fence(__ATOMIC_ACQUIRE, "agent");
            asm volatile("s_waitcnt vmcnt(0)" ::: "memory");
        }
    }
    __syncthreads();
}

typedef unsigned short bf16_t;
typedef float f32x4 __attribute__((ext_vector_type(4)));
typedef float f32x16 __attribute__((ext_vector_type(16)));
typedef short bf16x8 __attribute__((ext_vector_type(8)));
typedef unsigned u32x4 __attribute__((ext_vector_type(4)));
typedef unsigned u32x2 __attribute__((ext_vector_type(2)));

constexpr int S = 8192, DM = 2048, FF = 8192, NIN = 5168, NINP = 5376;
constexpr size_t HS128 = (size_t)S * 128;
constexpr size_t MiB = 1u << 20;
constexpr size_t W_IN_SZ = (size_t)NINP * DM, W_C_SZ = (size_t)2 * 1024 * 2048, W_2_SZ = (size_t)2 * 128 * 512, W_O_SZ = (size_t)DM * DM;
constexpr size_t W_NSA_SZ = W_IN_SZ + W_C_SZ + W_2_SZ + W_O_SZ;
constexpr size_t WOFF_NSA = 0;
constexpr size_t WOFF_QKV = 2 * W_NSA_SZ;
constexpr size_t WOFF_Q3 = WOFF_QKV + (size_t)3072 * DM;
constexpr size_t WOFF_DWO = WOFF_Q3 + (size_t)DM * DM;
constexpr size_t WOFF_UP = WOFF_DWO + 2 * (size_t)DM * DM;
constexpr size_t WOFF_DN = WOFF_UP + 4 * (size_t)FF * DM;
constexpr size_t W_TOTAL = WOFF_DN + 4 * (size_t)FF * DM;
constexpr size_t WS_W = 2 * MiB;
static_assert(WS_W + W_TOTAL * 2 <= 370 * MiB, "weight region");
constexpr size_t WS_X = 372 * MiB, WS_XN = 436 * MiB, WS_O = 468 * MiB, WS_KD = 500 * MiB, WS_VD = 516 * MiB;
constexpr size_t WS_GATES = 524 * MiB, WS_STATS = 526 * MiB, WS_MASK = 527 * MiB, WS_TAB = 528 * MiB, WS_IMP = 530 * MiB;
constexpr size_t WS_R = 546 * MiB;
constexpr size_t WS_SLOT = WS_R, WS_QROT = WS_R + 80 * MiB, WS_PART = WS_R + 112 * MiB, WS_KC2 = WS_R + 176 * MiB;
constexpr size_t WS_OC = WS_R + 178 * MiB, WS_OW = WS_R + 210 * MiB, WS_OS = WS_R + 242 * MiB;
constexpr size_t WS_U = WS_R, WS_QD = WS_R, WS_OD = WS_R + 64 * MiB;
constexpr size_t WS_END = WS_R + 274 * MiB;
constexpr size_t TAB_COSA = 0, TAB_SINA = (size_t)S * 16 * 4, TAB_COSB = 2 * (size_t)S * 16 * 4, TAB_SINB = TAB_COSB + (size_t)S * 8 * 4, TAB_BIASP = TAB_SINB + (size_t)S * 8 * 4;

constexpr size_t WS_ROWSS = 1 * MiB;
constexpr int LDS_RSTD = 131072 + 1024, RSTD_SLOTS = 16;
constexpr int LDS_BYTES = LDS_RSTD + RSTD_SLOTS * 1024;

struct Params { const float* in[17]; float* out; unsigned char* ws; int ph_lo, ph_hi; };
typedef const Params __attribute__((address_space(4))) * KParamsPtr;
__device__ __forceinline__ KParamsPtr lprm() { KParamsPtr p = (KParamsPtr)__builtin_amdgcn_kernarg_segment_ptr(); asm volatile("" : "+s"(p)); return p; }

struct Ctx { unsigned char* ws; char* lds; int tid, lane, wave, G, bid, gw, NGW; };

__device__ __forceinline__ float wave_sum(float v) {
#pragma unroll
    for (int o = 1; o < 64; o <<= 1) v += __shfl_xor(v, o);
    return v;
}
__device__ __forceinline__ unsigned pk2(float lo, float hi) { return pg8::cvt_pk_bf16(lo, hi); }
__device__ __forceinline__ float bf2f(unsigned short b) { return __uint_as_float(((unsigned)b) << 16); }

__device__ __forceinline__ void conv_item(const float* W, int N, int ldw, const float* g, bf16_t* WT, int ldt, int nblk, int item, int lane, LAS unsigned char* scr) {
    const int kb = item / nblk, nb = item % nblk, k0 = 64 * kb, n0 = 64 * nb, n4 = (lane & 15) * 4, kg = lane >> 4;
    const bool ok = (n0 + n4) < N; const float* src = W + (size_t)(k0 + 16 * kg) * ldw + (ok ? n0 + n4 : 0);
    f32x4 v[16];
#pragma unroll
    for (int i = 0; i < 16; ++i) v[i] = *(const f32x4*)(src + (size_t)i * ldw);
    if (g) {
#pragma unroll
        for (int i = 0; i < 16; ++i) v[i] = v[i] * g[k0 + 16 * kg + i];
    }
#pragma unroll
    for (int j = 0; j < 4; ++j) { u32x4 o0, o1;
        o0.x = pk2(v[0][j], v[1][j]); o0.y = pk2(v[2][j], v[3][j]); o0.z = pk2(v[4][j], v[5][j]); o0.w = pk2(v[6][j], v[7][j]);
        o1.x = pk2(v[8][j], v[9][j]); o1.y = pk2(v[10][j], v[11][j]); o1.z = pk2(v[12][j], v[13][j]); o1.w = pk2(v[14][j], v[15][j]);
        if (!ok) { o0 = (u32x4){0u, 0u, 0u, 0u}; o1 = o0; }
        *(LAS u32x4*)(scr + (n4 + j) * 144 + 32 * kg) = o0; *(LAS u32x4*)(scr + (n4 + j) * 144 + 32 * kg + 16) = o1; }
    asm volatile("s_waitcnt lgkmcnt(0)" ::: "memory");
#pragma unroll
    for (int i = 0; i < 8; ++i) { const int row = 8 * i + (lane >> 3), ch = lane & 7; const u32x4 o = *(const LAS u32x4*)(scr + row * 144 + ch * 16);
        *(u32x4*)(WT + (size_t)(n0 + row) * ldt + k0 + ch * 8) = o; }
    asm volatile("s_waitcnt lgkmcnt(0)" ::: "memory");
}
__device__ __forceinline__ void conv_matrix(const Ctx& C, const float* W, int K, int N, int NP, int ldw, const float* g, bf16_t* WT, int ldt, int& base) {
    const int nblk = NP / 64, nitems = (K / 64) * nblk; LAS unsigned char* scr = (LAS unsigned char*)C.lds + C.wave * (64 * 144);
    const int first = (C.gw + C.NGW - (base % C.NGW)) % C.NGW;
    for (int it = first; it < nitems; it += C.NGW) conv_item(W, N, ldw, g, WT, ldt, nblk, it, C.lane, scr);
    base += nitems;
}
__device__ __forceinline__ void norm_phase(const Ctx& C, const float* src, float* copy, bf16_t* xn, float* outf, const float* gain) {
    for (int row = C.gw; row < S; row += C.NGW) {
        const f32x4* xr = (const f32x4*)(src + (size_t)row * DM) + C.lane;
        f32x4 v[8]; float ss = 0.f;
#pragma unroll
        for (int j = 0; j < 8; ++j) { v[j] = xr[64 * j]; ss += (v[j].x * v[j].x + v[j].y * v[j].y) + (v[j].z * v[j].z + v[j].w * v[j].w); }
        const float rstd = 1.0f / sqrtf(wave_sum(ss) * (1.0f / DM) + 1e-6f);
        if (copy) { f32x4* cr = (f32x4*)(copy + (size_t)row * DM) + C.lane;
#pragma unroll
            for (int j = 0; j < 8; ++j) cr[64 * j] = v[j]; }
        if (xn) { u32x2* o8 = (u32x2*)(xn + (size_t)row * DM) + C.lane;
#pragma unroll
            for (int j = 0; j < 8; ++j) { u32x2 w; w.x = pk2(v[j].x * rstd, v[j].y * rstd); w.y = pk2(v[j].z * rstd, v[j].w * rstd); o8[64 * j] = w; } }
        if (outf) { f32x4* orow = (f32x4*)(outf + (size_t)row * DM) + C.lane; const f32x4* gr = (const f32x4*)gain + C.lane;
#pragma unroll
            for (int j = 0; j < 8; ++j) { const f32x4 gg = gr[64 * j]; orow[64 * j] = v[j] * rstd * gg; } }
    }
}

__device__ __forceinline__ void xb_phase(const Ctx& C, const float* src, bf16_t* xb, float* rowss) {
    for (int row = C.gw; row < S; row += C.NGW) {
        const f32x4* xr = (const f32x4*)(src + (size_t)row * DM) + C.lane;
        f32x4 v[8]; float ss = 0.f;
#pragma unroll
        for (int j = 0; j < 8; ++j) { v[j] = xr[64 * j]; ss += (v[j].x * v[j].x + v[j].y * v[j].y) + (v[j].z * v[j].z + v[j].w * v[j].w); }
        ss = wave_sum(ss);
        u32x2* o8 = (u32x2*)(xb + (size_t)row * DM) + C.lane;
#pragma unroll
        for (int j = 0; j < 8; ++j) { u32x2 w; w.x = pk2(v[j].x, v[j].y); w.y = pk2(v[j].z, v[j].w); o8[64 * j] = w; }
        if (C.lane < 32) rowss[(size_t)row * 32 + C.lane] = C.lane == 0 ? ss : 0.f;
    }
}
template <class Sched> __device__ __forceinline__ void rstd_prestep(const Ctx& C, const Sched& So, const float* rowss) {
    LAS float* R = (LAS float*)(C.lds + LDS_RSTD);
    pg8::Unit u;
    for (int i = 0; i < RSTD_SLOTS && So.next(i, u); ++i) {
        const int r = C.tid >> 1, hf = C.tid & 1; const float* p = rowss + (size_t)(u.pm * 256 + r) * 32 + hf * 16;
        const f32x4 a = *(const f32x4*)p, b = *(const f32x4*)(p + 4), c = *(const f32x4*)(p + 8), d = *(const f32x4*)(p + 12);
        float ss = ((a.x + a.y) + (a.z + a.w)) + ((b.x + b.y) + (b.z + b.w)) + ((c.x + c.y) + (c.z + c.w)) + ((d.x + d.y) + (d.z + d.w));
        ss += __shfl_xor(ss, 1);
        if (hf == 0) R[i * 256 + r] = 1.0f / sqrtf(ss * (1.0f / DM) + 1e-6f);
    }
    __syncthreads();
}
__device__ __forceinline__ void final_norm_phase(const Ctx& C, const bf16_t* xb, float* outf, const float* gain) {
    for (int row = C.gw; row < S; row += C.NGW) {
        const u32x2* xr = (const u32x2*)(xb + (size_t)row * DM) + C.lane;
        f32x4 v[8]; float ss = 0.f;
#pragma unroll
        for (int j = 0; j < 8; ++j) { const u32x2 w = xr[64 * j]; v[j] = (f32x4){__uint_as_float(w.x << 16), __uint_as_float(w.x & 0xffff0000u), __uint_as_float(w.y << 16), __uint_as_float(w.y & 0xffff0000u)};
            ss += (v[j].x * v[j].x + v[j].y * v[j].y) + (v[j].z * v[j].z + v[j].w * v[j].w); }
        const float rstd = 1.0f / sqrtf(wave_sum(ss) * (1.0f / DM) + 1e-6f);
        f32x4* orow = (f32x4*)(outf + (size_t)row * DM) + C.lane; const f32x4* gr = (const f32x4*)gain + C.lane;
#pragma unroll
        for (int j = 0; j < 8; ++j) { const f32x4 gg = gr[64 * j]; orow[64 * j] = v[j] * rstd * gg; }
    }
}
struct ZSched {
    int nM, nN, nZ, G, c; size_t aJ, aS, bJ, bS;
    __device__ __forceinline__ bool next(int i, pg8::Unit& u) const { const long L = (long)i * G + c; if (L >= (long)nM * nN * nZ) return false;
        const int per = nM * nN; u.pz = (int)(L / per); const int r = (int)(L % per); u.pm = r / nN; u.pn = r % nN; return true; }
    __device__ __forceinline__ void a_ready(const pg8::Unit&) const {}
    __device__ __forceinline__ void done(const pg8::Unit&) const {}
    __device__ __forceinline__ size_t aoff(const pg8::Unit& u) const { return (size_t)(u.pz >> 2) * aJ + (size_t)(u.pz & 3) * aS; }
    __device__ __forceinline__ size_t boff(const pg8::Unit& u) const { return (size_t)(u.pz >> 2) * bJ + (size_t)(u.pz & 3) * bS; }
};
typedef f32x4 AccT[2][2][4][2];
struct EpiIn {
    static constexpr bool PERM = true, AFTER_DRAIN = false;
    bf16_t* slot; bf16_t* qrot; float* gates; const float* cosA; const float* sinA; const LAS float* R;
    __device__ __forceinline__ void operator()(const AccT& acc, const pg8::Unit& u, int wr, int wc, int fr, int fq) const {
        const int row0 = u.pm * 256 + wr * 64 + fr; const LAS float* Ru = R + (u.pz & (RSTD_SLOTS - 1)) * 256 + wr * 64 + fr;
#pragma unroll
        for (int bj = 0; bj < 2; ++bj) {
            const int sl = 2 * u.pn + bj;
            if (sl > 40) continue;
            const int d0 = wc * 32 + 8 * fq;
            if (sl == 40) {
#pragma unroll
                for (int ai = 0; ai < 2; ++ai)
#pragma unroll
                    for (int m = 0; m < 4; ++m) { const int row = row0 + ai * 128 + m * 16; const float rs = Ru[ai * 128 + m * 16]; const f32x4 v0 = acc[ai][bj][m][0] * rs, v1 = acc[ai][bj][m][1] * rs;
#pragma unroll
                        for (int j = 0; j < 8; ++j) { const int c = d0 + j; const float x = j < 4 ? v0[j & 3] : v1[j & 3]; if (c < 48) gates[(size_t)row * 48 + c] = 1.0f / (1.0f + __expf(-x)); } }
                continue;
            }
            const bool isq = sl < 16;
            const bool rot = isq || (sl >= 24 && sl < 28) || (sl >= 32 && sl < 36);
            bf16_t* dst = slot + (size_t)sl * HS128;
            bf16_t* rdst = isq ? qrot + (size_t)sl * HS128 : dst;
#pragma unroll
            for (int ai = 0; ai < 2; ++ai)
#pragma unroll
                for (int m = 0; m < 4; ++m) { const int row = row0 + ai * 128 + m * 16; const float rs = Ru[ai * 128 + m * 16]; f32x4 v0 = acc[ai][bj][m][0] * rs, v1 = acc[ai][bj][m][1] * rs;
                    if (isq || !rot) { u32x4 w; w.x = pk2(v0[0], v0[1]); w.y = pk2(v0[2], v0[3]); w.z = pk2(v1[0], v1[1]); w.w = pk2(v1[2], v1[3]); *(u32x4*)(dst + (size_t)row * 128 + d0) = w; }
                    if (rot) {
                        if (wc == 0) {
                            const int i0 = 8 * (fq & 1);
                            const f32x4 c0 = *(const f32x4*)(cosA + (size_t)row * 16 + i0), c1 = *(const f32x4*)(cosA + (size_t)row * 16 + i0 + 4);
                            const f32x4 s0 = *(const f32x4*)(sinA + (size_t)row * 16 + i0), s1 = *(const f32x4*)(sinA + (size_t)row * 16 + i0 + 4);
                            f32x4 p0, p1;
#pragma unroll
                            for (int j = 0; j < 4; ++j) { p0[j] = __shfl_xor(v0[j], 32); p1[j] = __shfl_xor(v1[j], 32); }
                            const float sg = fq < 2 ? -1.f : 1.f;
                            v0 = v0 * c0 + (p0 * sg) * s0; v1 = v1 * c1 + (p1 * sg) * s1;
                        }
                        u32x4 w; w.x = pk2(v0[0], v0[1]); w.y = pk2(v0[2], v0[3]); w.z = pk2(v1[0], v1[1]); w.w = pk2(v1[2], v1[3]); *(u32x4*)(rdst + (size_t)row * 128 + d0) = w;
                    } }
        }
    }
};
struct EpiQ {
    static constexpr bool PERM = true, AFTER_DRAIN = false;
    bf16_t* qd; bf16_t* kd; bf16_t* vd; const float* cosB; const float* sinB; const LAS float* R;
    __device__ __forceinline__ void operator()(const AccT& acc, const pg8::Unit& u, int wr, int wc, int fr, int fq) const {
        const int row0 = u.pm * 256 + wr * 64 + fr; const LAS float* Ru = R + (u.pz & (RSTD_SLOTS - 1)) * 256 + wr * 64 + fr;
#pragma unroll
        for (int bj = 0; bj < 2; ++bj) {
            const int colh = u.pn * 256 + bj * 128;
            if (colh >= 2560) {
                bf16_t* dst = vd + (size_t)((colh - 2560) >> 7) * HS128; const int d0 = wc * 32 + 8 * fq;
#pragma unroll
                for (int ai = 0; ai < 2; ++ai)
#pragma unroll
                    for (int m = 0; m < 4; ++m) { const int row = row0 + ai * 128 + m * 16; const float rs = Ru[ai * 128 + m * 16]; const f32x4 v0 = acc[ai][bj][m][0] * rs, v1 = acc[ai][bj][m][1] * rs;
                        u32x4 w; w.x = pk2(v0[0], v0[1]); w.y = pk2(v0[2], v0[3]); w.z = pk2(v1[0], v1[1]); w.w = pk2(v1[2], v1[3]); *(u32x4*)(dst + (size_t)row * 128 + d0) = w; }
                continue;
            }
            const bool isq = colh < 2048;
            const int inst = (isq ? colh : colh - 2048) / 64 + (wc >> 1);
            bf16_t* dst = (isq ? qd : kd) + (size_t)inst * HS128;
            const float sc = isq ? 1.41421356237f : 1.0f;
            const int d0 = (wc & 1) * 32 + 8 * fq;
#pragma unroll
            for (int ai = 0; ai < 2; ++ai)
#pragma unroll
                for (int m = 0; m < 4; ++m) { const int row = row0 + ai * 128 + m * 16; const float rs = Ru[ai * 128 + m * 16]; f32x4 v0 = acc[ai][bj][m][0] * rs, v1 = acc[ai][bj][m][1] * rs;
                    if ((wc & 1) == 0) {
                        const f32x4 c0 = *(const f32x4*)(cosB + (size_t)row * 8), c1 = *(const f32x4*)(cosB + (size_t)row * 8 + 4);
                        const f32x4 s0 = *(const f32x4*)(sinB + (size_t)row * 8), s1 = *(const f32x4*)(sinB + (size_t)row * 8 + 4);
                        f32x4 p0, p1;
#pragma unroll
                        for (int j = 0; j < 4; ++j) { p0[j] = __shfl_xor(v0[j], 16); p1[j] = __shfl_xor(v1[j], 16); }
                        if (fq < 2) { const float sg = fq == 0 ? -1.f : 1.f; v0 = v0 * c0 + (p0 * sg) * s0; v1 = v1 * c1 + (p1 * sg) * s1; }
                    }
                    v0 = v0 * sc; v1 = v1 * sc;
                    u32x4 w; w.x = pk2(v0[0], v0[1]); w.y = pk2(v0[2], v0[3]); w.z = pk2(v1[0], v1[1]); w.w = pk2(v1[2], v1[3]);
                    *(u32x4*)(dst + (size_t)row * 128 + d0) = w; }
        }
    }
};
struct EpiUp {
    static constexpr bool PERM = true, AFTER_DRAIN = false;
    bf16_t* U; const LAS float* R;
    __device__ __forceinline__ void operator()(const AccT& acc, const pg8::Unit& u, int wr, int wc, int fr, int fq) const {
        const int row0 = u.pm * 256 + wr * 64 + fr, col0 = u.pn * 256 + wc * 32 + 8 * fq; const LAS float* Ru = R + (u.pz & (RSTD_SLOTS - 1)) * 256 + wr * 64 + fr;
#pragma unroll
        for (int ai = 0; ai < 2; ++ai)
#pragma unroll
            for (int m = 0; m < 4; ++m) { bf16_t* rowp = U + (size_t)(row0 + ai * 128 + m * 16) * FF + col0; const float rs = Ru[ai * 128 + m * 16];
#pragma unroll
                for (int bj = 0; bj < 2; ++bj) { f32x4 v0 = acc[ai][bj][m][0], v1 = acc[ai][bj][m][1];
#pragma unroll
                    for (int j = 0; j < 4; ++j) { const float a = fmaxf(v0[j] * rs, 0.f), b = fmaxf(v1[j] * rs, 0.f); v0[j] = a * a; v1[j] = b * b; }
                    u32x4 w; w.x = pk2(v0[0], v0[1]); w.y = pk2(v0[2], v0[3]); w.z = pk2(v1[0], v1[1]); w.w = pk2(v1[2], v1[3]); *(u32x4*)(rowp + bj * 128) = w; } }
    }
};
struct EpiRes {
    static constexpr bool PERM = false, AFTER_DRAIN = false;
    const float* X0; bf16_t* XB; float* rowss;
    __device__ __forceinline__ void operator()(const AccT& acc, const pg8::Unit& u, int wr, int wc, int fr, int fq) const {
        const int row0 = u.pm * 256 + wr * 64 + fr, col0 = u.pn * 256 + wc * 32 + 4 * fq;
#pragma unroll
        for (int ai = 0; ai < 2; ++ai)
#pragma unroll
            for (int m = 0; m < 4; ++m) { const int row = row0 + ai * 128 + m * 16; const size_t ro = (size_t)row * DM + col0; float ss = 0.f;
#pragma unroll
                for (int bj = 0; bj < 2; ++bj)
#pragma unroll
                    for (int n = 0; n < 2; ++n) { const size_t off = ro + bj * 128 + n * 16; f32x4 v;
                        if (X0) v = *(const f32x4*)(X0 + off);
                        else { const u32x2 w = *(const u32x2*)(XB + off); v = (f32x4){__uint_as_float(w.x << 16), __uint_as_float(w.x & 0xffff0000u), __uint_as_float(w.y << 16), __uint_as_float(w.y & 0xffff0000u)}; }
                        v = v + acc[ai][bj][m][n];
                        u32x2 w; w.x = pk2(v.x, v.y); w.y = pk2(v.z, v.w); *(u32x2*)(XB + off) = w;
                        const float r0 = __uint_as_float(w.x << 16), r1 = __uint_as_float(w.x & 0xffff0000u), r2 = __uint_as_float(w.y << 16), r3 = __uint_as_float(w.y & 0xffff0000u);
                        ss += (r0 * r0 + r1 * r1) + (r2 * r2 + r3 * r3); }
                ss += __shfl_xor(ss, 16); ss += __shfl_xor(ss, 32);
                if (fq == 0) rowss[(size_t)row * 32 + u.pn * 4 + wc] = ss; }
    }
};
struct EpiPart {
    static constexpr bool PERM = false, AFTER_DRAIN = false;
    float* P;
    __device__ __forceinline__ void operator()(const AccT& acc, const pg8::Unit& u, int wr, int wc, int fr, int fq) const {
        const int row0 = u.pm * 256 + wr * 64 + fr, col0 = u.pn * 256 + wc * 32 + 4 * fq;
        float* base = P + (size_t)u.pz * 2048 * 1024;
#pragma unroll
        for (int ai = 0; ai < 2; ++ai)
#pragma unroll
            for (int m = 0; m < 4; ++m) { float* rowp = base + (size_t)(row0 + ai * 128 + m * 16) * 1024 + col0;
#pragma unroll
                for (int bj = 0; bj < 2; ++bj)
#pragma unroll
                    for (int n = 0; n < 2; ++n) *(f32x4*)(rowp + bj * 128 + n * 16) = acc[ai][bj][m][n]; }
    }
};

__device__ __forceinline__ float gelu_tanh(float x) { const float u = 0.7978845608028654f * (x + 0.044715f * x * x * x); const float e = __expf(2.f * u); const float t = 1.f - 2.f / (e + 1.f); return 0.5f * x * (1.f + t); }
__device__ __forceinline__ void cmp2_phase(const Ctx& C, const float* part, const float* biasp, const bf16_t* w2t, bf16_t* kc2) {
    LAS bf16_t* Hs = (LAS bf16_t*)C.lds;
    for (int unit = C.bid; unit < 256; unit += C.G) {
        const int j = unit >> 7, R0 = (unit & 127) * 16;
        {   const int r = C.tid >> 5, c0 = (C.tid & 31) * 16; const int R = R0 + r;
            f32x4 a[4];
#pragma unroll
            for (int q = 0; q < 4; ++q) { a[q] = (f32x4){0.f, 0.f, 0.f, 0.f};
#pragma unroll
                for (int kc = 0; kc < 8; ++kc) a[q] = a[q] + *(const f32x4*)(biasp + ((size_t)j * 8 + kc) * 512 + c0 + 4 * q); }
#pragma unroll
            for (int sp = 0; sp < 4; ++sp) { const float* pz = part + (size_t)(j * 4 + sp) * 2048 * 1024;
#pragma unroll
                for (int q = 0; q < 4; ++q) a[q] = a[q] + *(const f32x4*)(pz + (size_t)R * 1024 + c0 + 4 * q) + *(const f32x4*)(pz + (size_t)(R + 1) * 1024 + 512 + c0 + 4 * q); }
#pragma unroll
            for (int q = 0; q < 4; ++q) { u32x2 w; w.x = pk2(gelu_tanh(a[q][0]), gelu_tanh(a[q][1])); w.y = pk2(gelu_tanh(a[q][2]), gelu_tanh(a[q][3])); *(LAS u32x2*)(Hs + r * 520 + c0 + 4 * q) = w; }
        }
        __syncthreads();
        {   const int fr = C.lane & 15, fq = C.lane >> 4; f32x4 acc = {0.f, 0.f, 0.f, 0.f};
            const bf16_t* brow = w2t + (size_t)j * 128 * 512 + (size_t)(16 * C.wave + fr) * 512 + 8 * fq;
#pragma unroll
            for (int kk = 0; kk < 16; ++kk) { const bf16x8 a = *(const LAS bf16x8*)(Hs + fr * 520 + kk * 32 + 8 * fq); const bf16x8 b = *(const bf16x8*)(brow + kk * 32);
                acc = __builtin_amdgcn_mfma_f32_16x16x32_bf16(a, b, acc, 0, 0, 0); }
#pragma unroll
            for (int r = 0; r < 4; ++r) { const int R = R0 + fq * 4 + r; float v = acc[r]; if ((R & 511) == 511) v = 0.f;
                const float vn = __shfl_xor(v, 1); if ((fr & 1) == 0) *(unsigned*)(kc2 + (size_t)j * 2048 * 128 + (size_t)R * 128 + 16 * C.wave + fr) = pk2(v, vn); }
        }
        __syncthreads();
    }
}
typedef fa::BlockRef<fa::bf16, fa::bf16> RefB;
typedef fa::BlockRef<fa::bf16, float> RefF;
constexpr int W_CAUSAL = 0x3fffffff;
__device__ __forceinline__ bool refA(const Ctx& C, int q, RefB& r) {
    const int pair = C.bid + (q >> 1) * C.G; if (pair >= 512) return false;
    const bool cmp = pair >= 256; const int pp = pair & 255, h = pp >> 4, p = pp & 15, qb = (q & 1) ? 31 - p : p, hk = h >> 2;
    const bf16_t* slot = (const bf16_t*)(C.ws + WS_SLOT); const size_t ro = (size_t)h * HS128 + (size_t)qb * 256 * 128;
    r.P0 = qb * 256; r.sel = nullptr; r.stats = nullptr;
    if (!cmp) {
        r.Q = (const fa::bf16*)((const bf16_t*)(C.ws + WS_QROT) + ro); r.K = (const fa::bf16*)(slot + (size_t)(32 + hk) * HS128); r.V = (const fa::bf16*)(slot + (size_t)(36 + hk) * HS128);
        r.O = (fa::bf16*)((bf16_t*)(C.ws + WS_OW) + ro); r.W = 512; const int lowk = r.P0 - 511; r.jlo = lowk > 0 ? lowk / 64 : 0; r.jhi = 4 * qb + 4; r.psub = 0; r.psh = 0;
    } else {
        r.Q = (const fa::bf16*)(slot + ro); r.K = (const fa::bf16*)((const bf16_t*)(C.ws + WS_KC2) + (size_t)hk * 512 * 128); r.V = (const fa::bf16*)((const bf16_t*)(C.ws + WS_KC2) + (size_t)2048 * 128 + (size_t)hk * 512 * 128);
        r.O = (fa::bf16*)((bf16_t*)(C.ws + WS_OC) + ro); r.W = W_CAUSAL; r.jlo = 0; r.jhi = (((r.P0 + 224) >> 4) >> 6) + 1; r.psub = 31; r.psh = 4;
        r.stats = (float2*)(C.ws + WS_STATS) + (size_t)h * S + qb * 256;
    }
    return true;
}
__device__ __forceinline__ bool refS(const Ctx& C, int q, RefB& r) {
    const int pair = C.bid + (q >> 1) * C.G; if (pair >= 256) return false;
    const int h = pair >> 4, p = pair & 15, qb = (q & 1) ? 31 - p : p, hk = h >> 2;
    const bf16_t* slot = (const bf16_t*)(C.ws + WS_SLOT); const size_t ro = (size_t)h * HS128 + (size_t)qb * 256 * 128;
    r.P0 = qb * 256; r.stats = nullptr; r.sel = (const fa::u32x4*)(C.ws + WS_MASK) + (size_t)hk * S + qb * 256;
    r.Q = (const fa::bf16*)((const bf16_t*)(C.ws + WS_QROT) + ro); r.K = (const fa::bf16*)(slot + (size_t)(24 + hk) * HS128); r.V = (const fa::bf16*)(slot + (size_t)(28 + hk) * HS128);
    r.O = (fa::bf16*)((bf16_t*)(C.ws + WS_OS) + ro); r.W = W_CAUSAL; r.jlo = 0; r.jhi = 4 * qb + 4; r.psub = 0; r.psh = 0;
    return true;
}
__device__ __forceinline__ bool refD(const Ctx& C, int q, RefF& r) {
    const int pair = C.bid + (q >> 1) * C.G; if (pair >= 512) return false;
    const int inst = pair >> 4, p = pair & 15, qb = (q & 1) ? 31 - p : p, hk = inst >> 3, c = inst & 1;
    const size_t ro = (size_t)inst * HS128 + (size_t)qb * 256 * 128;
    r.P0 = qb * 256; r.stats = nullptr; r.sel = nullptr;
    r.Q = (const fa::bf16*)((const bf16_t*)(C.ws + WS_QD) + ro); r.K = (const fa::bf16*)((const bf16_t*)(C.ws + WS_KD) + (size_t)(hk * 2 + c) * HS128); r.V = (const fa::bf16*)((const bf16_t*)(C.ws + WS_VD) + (size_t)hk * HS128);
    r.O = (float*)(C.ws + WS_OD) + ro; r.W = W_CAUSAL; r.jlo = 0; r.jhi = 4 * qb + 4; r.psub = 0; r.psh = 0;
    return true;
}
#define FLASH_STREAM(REFT, TOUT, HSEL, MK, NDV) do { struct NF_ { const Ctx& C; int q; __device__ __forceinline__ REFT operator()(const REFT& cur) const { REFT r; if (!MK(C, q, r)) r = cur; return r; } }; \
        REFT cur_; int q_ = 0; if (MK(C, 0, cur_)) { fa::Seam<fa::bf16> Sm = {}; fa::causal_swa_prime<fa::bf16, TOUT>(cur_, C.lds, Sm, C.tid); \
        for (;;) { const NF_ nf_{C, q_ + 1}; fa::causal_swa_block<fa::bf16, TOUT, HSEL, NF_, NDV>(cur_, nf_, C.lds, Sm, C.tid); REFT nxt_; if (!MK(C, q_ + 1, nxt_)) break; cur_ = nxt_; ++q_; } } } while (0)

__device__ __forceinline__ u32x4 select_blocks(const LAS float* ip, int cur, int lane) {
    unsigned w0 = 0u, w1 = 0u, w2 = 0u, w3 = 0u;
    if (cur <= 15) { w0 = (1u << (cur + 1)) - 1u; }
    else {
        const float v0 = fmaxf(ip[lane], 0.f), v1 = fmaxf(ip[lane + 64], 0.f);
        const int hi = cur - 2;
        const unsigned k0 = (lane >= 1 && lane <= hi) ? ((__float_as_uint(v0) & ~127u) | (unsigned)(127 - lane)) : 0u;
        const unsigned k1 = (lane + 64 <= hi) ? ((__float_as_uint(v1) & ~127u) | (unsigned)(63 - lane)) : 0u;
        unsigned T = 0u;
#pragma unroll 4
        for (int b = 30; b >= 0; --b) { const unsigned cand = T | (1u << b); const int cnt = __popcll(__ballot(k0 >= cand)) + __popcll(__ballot(k1 >= cand)); if (cnt >= 13) T = cand; }
        const unsigned long long m0 = __ballot(k0 != 0u && k0 >= T), m1 = __ballot(k1 != 0u && k1 >= T);
        w0 = (unsigned)m0; w1 = (unsigned)(m0 >> 32); w2 = (unsigned)m1; w3 = (unsigned)(m1 >> 32);
        w0 |= 1u;
#pragma unroll
        for (int e = 0; e < 2; ++e) { const int s = cur - e; const unsigned bit = 1u << (s & 31); const int sw = s >> 5;
            if (sw == 0) w0 |= bit; else if (sw == 1) w1 |= bit; else if (sw == 2) w2 |= bit; else w3 |= bit; }
    }
    return (u32x4){w0, w1, w2, w3};
}
__device__ __forceinline__ void imp_unit(const Ctx& C, int hk, int tb) {
    u32x4* maskp = (u32x4*)(C.ws + WS_MASK) + (size_t)hk * S + tb * 64;
    if (tb < 16) { if (C.lane < 8) maskp[C.wave * 8 + C.lane] = (u32x4){(1u << (tb + 1)) - 1u, 0u, 0u, 0u}; return; }
    const int w = C.wave, g = w >> 1, th = w & 1, lane = C.lane, r32 = lane & 31, hi = lane >> 5, h = hk * 4 + g;
    const int token = tb * 64 + th * 32 + r32;
    const bf16_t* Q = (const bf16_t*)(C.ws + WS_SLOT) + (size_t)h * HS128 + (size_t)token * 128;
    const bf16_t* Kc = (const bf16_t*)(C.ws + WS_KC2) + (size_t)hk * 512 * 128;
    bf16x8 qr[8];
#pragma unroll
    for (int d0 = 0; d0 < 8; ++d0) qr[d0] = *(const bf16x8*)(Q + d0 * 16 + hi * 8);
    const float2 st = ((const float2*)(C.ws + WS_STATS))[(size_t)h * S + token];
    constexpr float C2 = 1.4426950408889634f * fa::SCALE;
    const float mC2 = -st.x * C2, il = 1.0f / st.y;
    char* K_lds = C.lds; LAS float* red = (LAS float*)(C.lds + 16384);
    const int NT = ((4 * (tb - 2) + 3) >> 6) + 1;
    const int sr = C.tid >> 4, sc = (C.tid & 15) * 8, kws = KSWZ(sr, sc * 2);
    float carry = 0.f;
    LAS float* impl = (LAS float*)(C.lds + 32768);
    LAS float* impo = impl + (th * 32 + r32) * 128;
    bf16x8 kn0 = *(const bf16x8*)(Kc + (size_t)sr * 128 + sc), kn1 = *(const bf16x8*)(Kc + (size_t)(32 + sr) * 128 + sc);
    for (int t = 0; t < NT; ++t) {
        *(bf16x8*)(K_lds + kws) = kn0; *(bf16x8*)(K_lds + kws + 32 * 256) = kn1;
        if (t + 1 < NT) { kn0 = *(const bf16x8*)(Kc + (size_t)((t + 1) * 64 + sr) * 128 + sc); kn1 = *(const bf16x8*)(Kc + (size_t)((t + 1) * 64 + 32 + sr) * 128 + sc); }
        __syncthreads();
        f32x16 p0, p1;
        fa::qkt<0, false>(p0, p1, K_lds, r32, hi, qr, true);
#pragma unroll
        for (int r = 0; r < 16; ++r) { p0[r] = __builtin_amdgcn_exp2f(fmaf(p0[r], C2, mC2)) * il; p1[r] = __builtin_amdgcn_exp2f(fmaf(p1[r], C2, mC2)) * il; }
        float gs[2][4], ot[2][4];
#pragma unroll
        for (int a = 0; a < 4; ++a) { gs[0][a] = (p0[4 * a] + p0[4 * a + 1]) + (p0[4 * a + 2] + p0[4 * a + 3]); gs[1][a] = (p1[4 * a] + p1[4 * a + 1]) + (p1[4 * a + 2] + p1[4 * a + 3]);
            ot[0][a] = __shfl_xor(p0[4 * a + 3], 32); ot[1][a] = __shfl_xor(p1[4 * a + 3], 32); }
        float iv[2][4];
#pragma unroll
        for (int H = 0; H < 2; ++H)
#pragma unroll
            for (int a = 0; a < 4; ++a) { float prev; if (hi) prev = ot[H][a]; else prev = a > 0 ? ot[H][a - 1] : (H == 1 ? ot[0][3] : carry); iv[H][a] = gs[H][a] + prev; }
        carry = ot[1][3];
        { LAS f32x4* rp = (LAS f32x4*)(red + ((g * 2 + th) * 64 + lane) * 8); rp[0] = (f32x4){iv[0][0], iv[0][1], iv[0][2], iv[0][3]}; rp[1] = (f32x4){iv[1][0], iv[1][1], iv[1][2], iv[1][3]}; }
        __syncthreads();
        if (g == 0) {
            f32x4 a0 = {0.f, 0.f, 0.f, 0.f}, a1 = a0;
#pragma unroll
            for (int gg = 0; gg < 4; ++gg) { const LAS f32x4* rp = (const LAS f32x4*)(red + ((gg * 2 + th) * 64 + lane) * 8); a0 = a0 + rp[0]; a1 = a1 + rp[1]; }
#pragma unroll
            for (int a = 0; a < 4; ++a) { impo[16 * t + 2 * a + hi] = a0[a]; impo[16 * t + 8 + 2 * a + hi] = a1[a]; }
        }
    }
    __syncthreads();
    for (int j = 0; j < 8; ++j) { const int tt = C.wave * 8 + j; const u32x4 m = select_blocks(impl + tt * 128, tb, C.lane); if (C.lane == 0) maskp[tt] = m; }
    __syncthreads();
}
__device__ __forceinline__ void imp_phase(const Ctx& C) {
    for (int pair = C.bid; pair < 256; pair += C.G) { const int hk = pair >> 6, p = pair & 63; imp_unit(C, hk, p); imp_unit(C, hk, 127 - p); }
}
__device__ __forceinline__ void topk_phase(const Ctx& C) {
    const float* imp = (const float*)(C.ws + WS_IMP); u32x4* mask = (u32x4*)(C.ws + WS_MASK);
    for (int item0 = C.gw; item0 < 4 * S; item0 += 4 * C.NGW) {
      float pv0[4], pv1[4];
#pragma unroll
      for (int u = 0; u < 4; ++u) { const int it_ = item0 + u * C.NGW; const float* ip = imp + (size_t)(it_ < 4 * S ? it_ : item0) * 128; pv0[u] = ip[C.lane]; pv1[u] = ip[C.lane + 64]; }
#pragma unroll
      for (int u = 0; u < 4; ++u) { const int item = item0 + u * C.NGW; if (item >= 4 * S) break;
        const int token = item & (S - 1), cur = token >> 6, lane = C.lane;
        unsigned w0 = 0u, w1 = 0u, w2 = 0u, w3 = 0u;
        if (cur <= 15) { w0 = (1u << (cur + 1)) - 1u; }
        else {
            const float v0 = fmaxf(pv0[u], 0.f), v1 = fmaxf(pv1[u], 0.f);
            const int hi = cur - 2;
            const unsigned k0 = (lane >= 1 && lane <= hi) ? ((__float_as_uint(v0) & ~127u) | (unsigned)(127 - lane)) : 0u;
            const unsigned k1 = (lane + 64 <= hi) ? ((__float_as_uint(v1) & ~127u) | (unsigned)(63 - lane)) : 0u;
            unsigned T = 0u;
#pragma unroll 4
            for (int b = 30; b >= 0; --b) { const unsigned cand = T | (1u << b); const int cnt = __popcll(__ballot(k0 >= cand)) + __popcll(__ballot(k1 >= cand)); if (cnt >= 13) T = cand; }
            const unsigned long long m0 = __ballot(k0 != 0u && k0 >= T), m1 = __ballot(k1 != 0u && k1 >= T);
            w0 = (unsigned)m0; w1 = (unsigned)(m0 >> 32); w2 = (unsigned)m1; w3 = (unsigned)(m1 >> 32);
            w0 |= 1u;
#pragma unroll
            for (int e = 0; e < 2; ++e) { const int s = cur - e; const unsigned bit = 1u << (s & 31); const int sw = s >> 5;
                if (sw == 0) w0 |= bit; else if (sw == 1) w1 |= bit; else if (sw == 2) w2 |= bit; else w3 |= bit; }
        }
        if (lane == 0) mask[item] = (u32x4){w0, w1, w2, w3};
      }
    }
}
__device__ __forceinline__ void combine_nsa(const Ctx& C) {
    const bf16_t* OC = (const bf16_t*)(C.ws + WS_OC); const bf16_t* OS = (const bf16_t*)(C.ws + WS_OS); const bf16_t* OW = (const bf16_t*)(C.ws + WS_OW);
    const float* gates = (const float*)(C.ws + WS_GATES); bf16_t* O = (bf16_t*)(C.ws + WS_O);
    const int lg = C.lane >> 4, d = (C.lane & 15) * 8;
    for (int it4 = C.gw; it4 < S * 16 / 4; it4 += 2 * C.NGW) {
        u32x4 a[2], b[2], c[2]; float g0[2], g1[2], g2[2]; int tok[2], hh[2];
#pragma unroll
        for (int u = 0; u < 2; ++u) { int it = it4 + u * C.NGW; if (it >= S * 16 / 4) it = it4; const int item = it * 4 + lg; tok[u] = item >> 4; hh[u] = item & 15;
            g0[u] = gates[(size_t)tok[u] * 48 + hh[u] * 3]; g1[u] = gates[(size_t)tok[u] * 48 + hh[u] * 3 + 1]; g2[u] = gates[(size_t)tok[u] * 48 + hh[u] * 3 + 2];
            const size_t off = (size_t)hh[u] * HS128 + (size_t)tok[u] * 128 + d; a[u] = *(const u32x4*)(OC + off); b[u] = *(const u32x4*)(OS + off); c[u] = *(const u32x4*)(OW + off); }
#pragma unroll
        for (int u = 0; u < 2; ++u) { if (u == 1 && it4 + C.NGW >= S * 16 / 4) break;
            u32x4 o;
#pragma unroll
            for (int j = 0; j < 4; ++j) { const unsigned ua = a[u][j], ub = b[u][j], uc = c[u][j];
                const float lo = g0[u] * __uint_as_float(ua << 16) + g1[u] * __uint_as_float(ub << 16) + g2[u] * __uint_as_float(uc << 16);
                const float hv = g0[u] * __uint_as_float(ua & 0xffff0000u) + g1[u] * __uint_as_float(ub & 0xffff0000u) + g2[u] * __uint_as_float(uc & 0xffff0000u);
                o[j] = pk2(lo, hv); }
            *(u32x4*)(O + (size_t)tok[u] * DM + hh[u] * 128 + d) = o; }
    }
}
__device__ __forceinline__ void combine_diff(const Ctx& C, KParamsPtr prm, int jl) {
    const float* lv = prm->in[12] + (size_t)jl * 4 * 64; const float* sg = prm->in[13] + (size_t)jl * 128;
    const float linit = jl == 0 ? 0.47071301834358416f : 0.5560582041556405f;
    const float d1 = wave_sum(lv[C.lane] * lv[64 + C.lane]), d2 = wave_sum(lv[128 + C.lane] * lv[192 + C.lane]);
    const float lam = expf(d1) - expf(d2) + linit;
    const float* OD = (const float*)(C.ws + WS_OD); bf16_t* O = (bf16_t*)(C.ws + WS_O);
    const int lg = C.lane >> 4, d = (C.lane & 15) * 8;
    const f32x4 ga = *(const f32x4*)(sg + d), gb = *(const f32x4*)(sg + d + 4);
    for (int it4 = C.gw; it4 < S * 16 / 4; it4 += C.NGW) {
        const int item = it4 * 4 + lg, token = item >> 4, h = item & 15;
        const size_t o1 = (size_t)(h * 2) * HS128 + (size_t)token * 128 + d, o2 = o1 + HS128;
        f32x4 a0 = *(const f32x4*)(OD + o1), a1 = *(const f32x4*)(OD + o1 + 4); const f32x4 b0 = *(const f32x4*)(OD + o2), b1 = *(const f32x4*)(OD + o2 + 4);
        a0 = a0 - b0 * lam; a1 = a1 - b1 * lam;
        float ss = (a0.x * a0.x + a0.y * a0.y) + (a0.z * a0.z + a0.w * a0.w) + (a1.x * a1.x + a1.y * a1.y) + (a1.z * a1.z + a1.w * a1.w);
        ss += __shfl_xor(ss, 1); ss += __shfl_xor(ss, 2); ss += __shfl_xor(ss, 4); ss += __shfl_xor(ss, 8);
        const float r = (1.0f / sqrtf(ss * (1.0f / 128.0f) + 1e-6f)) * (1.0f - linit);
        a0 = a0 * r * ga; a1 = a1 * r * gb;
        u32x4 o; o.x = pk2(a0.x, a0.y); o.y = pk2(a0.z, a0.w); o.z = pk2(a1.x, a1.y); o.w = pk2(a1.z, a1.w);
        *(u32x4*)(O + (size_t)token * DM + h * 128 + d) = o;
    }
}
__device__ __forceinline__ void prologue(const Ctx& C, KParamsPtr prm) {
    bf16_t* Wb = (bf16_t*)(C.ws + WS_W); int cbase = 0;
    const float* attn_g = prm->in[1]; const float* mlp_g = prm->in[2];
    for (int l = 0; l < 2; ++l) {
        bf16_t* base = Wb + WOFF_NSA + (size_t)l * W_NSA_SZ;
        conv_matrix(C, prm->in[4] + (size_t)l * DM * NIN, DM, NIN, NINP, NIN, attn_g + l * DM, base, DM, cbase);
        for (int j = 0; j < 2; ++j) for (int hf = 0; hf < 2; ++hf)
            conv_matrix(C, prm->in[6] + ((size_t)(l * 2 + j) * 4096 + (size_t)hf * 2048) * 512, 2048, 512, 512, 512, nullptr, base + W_IN_SZ + ((size_t)j * 1024 + (size_t)hf * 512) * 2048, 2048, cbase);
        for (int j = 0; j < 2; ++j) conv_matrix(C, prm->in[7] + (size_t)(l * 2 + j) * 512 * 128, 512, 128, 128, 128, nullptr, base + W_IN_SZ + W_C_SZ + (size_t)j * 128 * 512, 512, cbase);
        conv_matrix(C, prm->in[8] + (size_t)l * DM * DM, DM, DM, DM, DM, nullptr, base + W_IN_SZ + W_C_SZ + W_2_SZ, DM, cbase);
    }
    conv_matrix(C, prm->in[11], DM, DM, DM, DM, attn_g + 2 * DM, Wb + WOFF_QKV, DM, cbase);
    conv_matrix(C, prm->in[10], DM, 1024, 1024, 1024, prm->in[9], Wb + WOFF_QKV + (size_t)DM * DM, DM, cbase);
    conv_matrix(C, prm->in[11] + (size_t)DM * DM, DM, DM, DM, DM, attn_g + 3 * DM, Wb + WOFF_Q3, DM, cbase);
    for (int j = 0; j < 2; ++j) conv_matrix(C, prm->in[14] + (size_t)j * DM * DM, DM, DM, DM, DM, nullptr, Wb + WOFF_DWO + (size_t)j * DM * DM, DM, cbase);
    for (int l = 0; l < 4; ++l) {
        conv_matrix(C, prm->in[15] + (size_t)l * DM * FF, DM, FF, FF, FF, mlp_g + l * DM, Wb + WOFF_UP + (size_t)l * FF * DM, DM, cbase);
        conv_matrix(C, prm->in[16] + (size_t)l * FF * DM, FF, DM, DM, DM, nullptr, Wb + WOFF_DN + (size_t)l * FF * DM, FF, cbase);
    }
    { float* cosA = (float*)(C.ws + WS_TAB + TAB_COSA); float* sinA = (float*)(C.ws + WS_TAB + TAB_SINA); float* cosB = (float*)(C.ws + WS_TAB + TAB_COSB); float* sinB = (float*)(C.ws + WS_TAB + TAB_SINB);
      const int gt = C.bid * 512 + C.tid, NT = C.G * 512;
      for (int idx = gt; idx < S * 16; idx += NT) { const int pos = idx >> 4, i = idx & 15; const float inv = 1.0f / powf(500000.0f, (float)(2 * i) / 32.0f); const float ang = (float)pos * inv;
          float sn, cs; sincosf(ang, &sn, &cs); cosA[idx] = cs; sinA[idx] = sn; if ((i & 1) == 0) { cosB[pos * 8 + (i >> 1)] = cs; sinB[pos * 8 + (i >> 1)] = sn; } } }
    __syncthreads();
    { float* biasp = (float*)(C.ws + WS_TAB + TAB_BIASP); LAS float* red = (LAS float*)C.lds;
      for (int u = C.bid; u < 256; u += C.G) { const int lj = u >> 6, kc = (u >> 3) & 7, cgp = u & 7, c = cgp * 64 + C.lane;
          const float* pos = prm->in[5] + (size_t)lj * 4096 + kc * 512 + C.wave * 64; const float* w1 = prm->in[6] + ((size_t)lj * 4096 + kc * 512 + C.wave * 64) * 512 + c;
          float v[64];
#pragma unroll
          for (int k = 0; k < 64; ++k) v[k] = w1[(size_t)k * 512];
          float a = 0.f;
#pragma unroll
          for (int k = 0; k < 64; ++k) a = fmaf(pos[k], v[k], a);
          red[C.wave * 64 + C.lane] = a;
          __syncthreads();
          if (C.wave == 0) { float t = 0.f;
#pragma unroll
              for (int w = 0; w < 8; ++w) t += red[w * 64 + C.lane];
              biasp[((size_t)lj * 8 + kc) * 512 + c] = t; }
          __syncthreads(); } }
    xb_phase(C, prm->in[0], (bf16_t*)(C.ws + WS_XN), (float*)(C.ws + WS_ROWSS));
}

#ifndef EN_G1
#define EN_G1 1
#endif
#ifndef EN_G2
#define EN_G2 1
#endif
#ifndef EN_G3
#define EN_G3 1
#endif
#ifndef EN_G4
#define EN_G4 1
#endif
#ifndef EN_G5
#define EN_G5 1
#endif
#ifndef EN_G6
#define EN_G6 1
#endif
#ifndef EN_G7
#define EN_G7 1
#endif
#ifndef EN_FA
#define EN_FA 1
#endif
#ifndef EN_FS
#define EN_FS 1
#endif
#ifndef EN_FD
#define EN_FD 1
#endif
#ifndef EN_GEMM
#define EN_GEMM 1
#endif
#ifndef EN_IMP
#define EN_IMP 1
#endif
#ifndef EN_PRO
#define EN_PRO 1
#endif

#ifdef TEST_MIN
__global__ void __launch_bounds__(512, 2) test_min(Params prm) {
    extern __shared__ __attribute__((aligned(16))) unsigned char lds_raw2[];
    LAS unsigned char* glds = (LAS unsigned char*)lds_raw2;
    bf16_t* Wb = (bf16_t*)(prm.ws + WS_W); float* X = (float*)(prm.ws + WS_X); bf16_t* Obuf = (bf16_t*)(prm.ws + WS_O);
#if TEST_MIN == 1
    pg8::Gemm g{Obuf, Wb, S, DM, DM, DM, DM}; pg8::StaticOrder So; So.init(S, DM, gridDim.x, blockIdx.x);
    EpiRes E{X}; pg8::gemm_phase<EpiRes, pg8::StaticOrder, true, true>(glds, g, So, E, C.tid);
#elif TEST_MIN == 2
    pg8::Gemm g{Obuf, Wb, S, DM, DM, DM, DM}; pg8::StaticOrder So; So.init(S, DM, gridDim.x, blockIdx.x);
    EpiUp E{Obuf}; pg8::gemm_phase<EpiUp, pg8::StaticOrder, true, true>(glds, g, So, E, C.tid);
#endif
}
#endif
enum { K_PRO = 0, K_WIN, K_CMP1, K_CMP2, K_FA, K_IMP, K_TOPK, K_FS, K_COMBN, K_RES, K_NORM, K_UP, K_QPROJ, K_FD, K_COMBD };
__global__ void __launch_bounds__(512, 2) yoco_fwd(Params prm) {
    extern __shared__ __attribute__((aligned(16))) unsigned char lds_raw[];
    cg::grid_group grid = cg::this_grid();
    const int lo = prm.ph_lo, hi = prm.ph_hi;
    const int wave_s = __builtin_amdgcn_readfirstlane((int)threadIdx.x >> 6);
    if (threadIdx.x < 64) ((volatile LAS unsigned*)(lds_raw + 131072))[threadIdx.x] = 0u;
    if (blockIdx.x == 0) { for (int i = threadIdx.x; i < XCD_BAR_WORDS; i += 512) ((unsigned*)prm.ws)[i] = 0u; }
    __syncthreads();
    XcdBarrier bar; bar.bar = (unsigned*)prm.ws; bar.x = 0; bar.st = nullptr;
    bool rep_done = false, bar_ready = false;
    for (int ph = lo; ph < hi; ++ph) {
        int l = 0, kind = K_PRO; bool is_down = false;
        if (ph >= 33) { kind = K_NORM; l = 3; }
        else if (ph >= 21) { const int r = ph - 21; l = 2 + r / 6; const int sub = r % 6; is_down = sub == 5;
            kind = sub == 0 ? K_QPROJ : sub == 1 ? K_FD : sub == 2 ? K_COMBD : sub == 3 ? K_RES : sub == 4 ? K_UP : K_RES; }
        else if (ph >= 1) { const int r = ph - 1; l = r / 10; const int sub = r % 10; is_down = sub == 9;
            kind = sub == 0 ? K_WIN : sub == 1 ? K_CMP1 : sub == 2 ? K_CMP2 : sub == 3 ? K_FA : sub == 4 ? K_IMP : sub == 5 ? K_FS : sub == 6 ? K_COMBN : sub == 7 ? K_RES : sub == 8 ? K_UP : K_RES; }
#define MKCTX const KParamsPtr kp_ = lprm(); Ctx C; C.ws = kp_->ws; C.lds = (char*)lds_raw; C.tid = mktid(wave_s); C.lane = C.tid & 63; C.wave = __builtin_amdgcn_readfirstlane(C.tid >> 6); C.G = lgrid(); C.bid = lbid(); C.gw = C.bid * 8 + C.wave; C.NGW = C.G * 8; \
        LAS unsigned char* glds = (LAS unsigned char*)lds_raw; bf16_t* Wb = (bf16_t*)(C.ws + WS_W); float* X = (float*)(C.ws + WS_X); bf16_t* XN = (bf16_t*)(C.ws + WS_XN); bf16_t* Obuf = (bf16_t*)(C.ws + WS_O); bf16_t* U = (bf16_t*)(C.ws + WS_U); \
        bf16_t* wl = Wb + WOFF_NSA + (size_t)(l & 1) * W_NSA_SZ; const int jl = l - 2; (void)glds; (void)X; (void)XN; (void)Obuf; (void)U; (void)wl; (void)jl;
        switch (kind) {
        case K_PRO: { MKCTX prologue(C, kp_); } break;
        case K_WIN: { MKCTX
            pg8::Gemm g{XN, wl, S, NINP, DM, DM, DM}; pg8::StaticOrder So; So.init(S, NINP, C.G, C.bid);
            EpiIn E{(bf16_t*)(C.ws + WS_SLOT), (bf16_t*)(C.ws + WS_QROT), (float*)(C.ws + WS_GATES), (const float*)(C.ws + WS_TAB + TAB_COSA), (const float*)(C.ws + WS_TAB + TAB_SINA), (const LAS float*)(C.lds + LDS_RSTD)};
            rstd_prestep(C, So, (const float*)(C.ws + WS_ROWSS));
            pg8::gemm_phase<EpiIn, pg8::StaticOrder, true, true>(glds, g, So, E, C.tid); } break;
        case K_CMP1: { MKCTX
            pg8::Gemm g{(const bf16_t*)(C.ws + WS_SLOT) + 16 * HS128, wl + W_IN_SZ, 2048, 1024, 512, 2048, 2048};
            ZSched Z{8, 4, 8, C.G, C.bid, (size_t)4 * HS128 * 2, (size_t)512 * 2, (size_t)1024 * 2048 * 2, (size_t)512 * 2};
            EpiPart E{(float*)(C.ws + WS_PART)};
            pg8::gemm_phase<EpiPart, ZSched, true, true>(glds, g, Z, E, C.tid); } break;
        case K_CMP2: { MKCTX cmp2_phase(C, (const float*)(C.ws + WS_PART), (const float*)(C.ws + WS_TAB + TAB_BIASP) + (size_t)l * 2 * 8 * 512, wl + W_IN_SZ + W_C_SZ, (bf16_t*)(C.ws + WS_KC2)); } break;
        case K_FA: { MKCTX FLASH_STREAM(RefB, fa::bf16, false, refA, 8); } break;
        case K_IMP: { MKCTX imp_phase(C); } break;
        case K_TOPK: { MKCTX topk_phase(C); } break;
        case K_FS: { MKCTX FLASH_STREAM(RefB, fa::bf16, true, refS, 8); } break;
        case K_COMBN: { MKCTX combine_nsa(C); } break;
        case K_RES: { MKCTX
            const bf16_t* Wt = is_down ? Wb + WOFF_DN + (size_t)l * FF * DM : (l < 2 ? wl + W_IN_SZ + W_C_SZ + W_2_SZ : Wb + WOFF_DWO + (size_t)jl * DM * DM);
            const int K = is_down ? FF : DM;
            pg8::Gemm g{is_down ? U : Obuf, Wt, S, DM, K, K, K}; pg8::StaticOrder So; So.init(S, DM, C.G, C.bid);
            EpiRes E{(l == 0 && !is_down) ? kp_->in[0] : (const float*)nullptr, XN, (float*)(C.ws + WS_ROWSS)}; pg8::gemm_phase<EpiRes, pg8::StaticOrder, true, true>(glds, g, So, E, C.tid); } break;
        case K_NORM: { MKCTX final_norm_phase(C, XN, kp_->out, kp_->in[3]); } break;
        case K_UP: { MKCTX
            pg8::Gemm g{XN, Wb + WOFF_UP + (size_t)l * FF * DM, S, FF, DM, DM, DM}; pg8::StaticOrder So; So.init(S, FF, C.G, C.bid);
            EpiUp E{U, (const LAS float*)(C.lds + LDS_RSTD)}; rstd_prestep(C, So, (const float*)(C.ws + WS_ROWSS)); pg8::gemm_phase<EpiUp, pg8::StaticOrder, true, true>(glds, g, So, E, C.tid); } break;
        case K_QPROJ: { MKCTX
            const int N = jl == 0 ? 3072 : 2048;
            pg8::Gemm g{XN, jl == 0 ? Wb + WOFF_QKV : Wb + WOFF_Q3, S, N, DM, DM, DM}; pg8::StaticOrder So; So.init(S, N, C.G, C.bid);
            EpiQ E{(bf16_t*)(C.ws + WS_QD), (bf16_t*)(C.ws + WS_KD), (bf16_t*)(C.ws + WS_VD), (const float*)(C.ws + WS_TAB + TAB_COSB), (const float*)(C.ws + WS_TAB + TAB_SINB), (const LAS float*)(C.lds + LDS_RSTD)};
            rstd_prestep(C, So, (const float*)(C.ws + WS_ROWSS));
            pg8::gemm_phase<EpiQ, pg8::StaticOrder, true, true>(glds, g, So, E, C.tid); } break;
        case K_FD: { MKCTX FLASH_STREAM(RefF, float, false, refD, 4); } break;
        case K_COMBD: { MKCTX combine_diff(C, kp_, jl); } break;
        default: break;
        }
        if (ph + 1 < hi) {
            const bool t0_ = mktid(wave_s) == 0;
            if (!bar_ready) { bar_ready = true; grid.sync(); bar = xcd_barrier_post(bar.bar, (volatile LAS unsigned*)(lds_raw + 131072), t0_); }
            else { xcd_barrier(bar, t0_); if (PROBE == 1) xcd_barrier(bar, t0_); }
        }
        if (PROBE >= 2) { if (kind == PROBE - 2 && !rep_done) { rep_done = true; --ph; } else rep_done = false; }
    }
}
constexpr int N_PHASES = 1 + 2 * 10 + 2 * 6 + 1;

#ifndef MK_MULTI
#define MK_MULTI 0
#endif
extern "C" void kernel_launch(void* const* d_in, const int* in_sizes, int n_in, void* d_out, int out_size, void* d_ws, size_t ws_size, hipStream_t stream) {
    static int grid = 0;
    if (grid == 0) {
        if (n_in != 17 || ws_size < WS_END) { fprintf(stderr, "kernel_launch: unexpected n_in %d / ws_size %zu (need %zu)\n", n_in, ws_size, (size_t)WS_END); grid = -1; return; }
        int dev = 0, cus = 0, per_cu = 0;
        (void)hipGetDevice(&dev); (void)hipDeviceGetAttribute(&cus, hipDeviceAttributeMultiprocessorCount, dev);
        if (hipFuncSetAttribute((const void*)yoco_fwd, hipFuncAttributeMaxDynamicSharedMemorySize, LDS_BYTES) != hipSuccess) { fprintf(stderr, "kernel_launch: hipFuncSetAttribute failed\n"); }
        if (hipOccupancyMaxActiveBlocksPerMultiprocessor(&per_cu, (const void*)yoco_fwd, 512, LDS_BYTES) != hipSuccess || per_cu < 1) { fprintf(stderr, "kernel_launch: occupancy query gave %d\n", per_cu); per_cu = 1; }
        (void)hipGetLastError();
        if (cus <= 0) cus = 256;
        grid = cus;
    }
    if (grid < 0) return;
    Params p{};
    for (int i = 0; i < 17; ++i) p.in[i] = (const float*)d_in[i];
    p.out = (float*)d_out; p.ws = (unsigned char*)d_ws;
#if MK_MULTI
    for (int ph = 0; ph < N_PHASES; ++ph) { p.ph_lo = ph; p.ph_hi = ph + 1; hipLaunchKernelGGL(yoco_fwd, dim3(grid), dim3(512), LDS_BYTES, stream, p); }
#else
    p.ph_lo = 0; p.ph_hi = N_PHASES;
    void* args[] = {&p};
    hipError_t e = hipLaunchCooperativeKernel((const void*)yoco_fwd, dim3(grid), dim3(512), args, LDS_BYTES, stream);
    if (e != hipSuccess) fprintf(stderr, "cooperative launch failed: %s (grid %d)\n", hipGetErrorString(e), grid);
#endif
}
```

```cpp
#include <hip/hip_runtime.h>
#include <hip/hip_bf16.h>
#include <hip/hip_cooperative_groups.h>
#include <cstdio>
#include <cstdint>
namespace cg = cooperative_groups;
#ifndef PROBE
#define PROBE 0
#endif
__device__ __forceinline__ int mktid(int wave_s) { int t; asm volatile("v_mbcnt_lo_u32_b32 %0, -1, 0\n\tv_mbcnt_hi_u32_b32 %0, -1, %0\n\tv_lshl_or_b32 %0, %1, 6, %0" : "=&v"(t) : "s"(wave_s)); return t; }
__device__ __forceinline__ float ozero() { float z; asm volatile("v_mov_b32 %0, 0" : "=v"(z)); return z; }
__device__ __forceinline__ int lbid() { int b = blockIdx.x; asm volatile("" : "+s"(b)); return b; }
__device__ __forceinline__ int lgrid() { int g = gridDim.x; asm volatile("" : "+s"(g)); return g; }
namespace pg8 {
#define PG8_LAS __attribute__((address_space(3)))
typedef unsigned short bf16_t;
typedef short bf16x8 __attribute__((ext_vector_type(8)));
typedef float f32x4 __attribute__((ext_vector_type(4)));
typedef unsigned u32x4 __attribute__((ext_vector_type(4)));
constexpr int BM = 256, BK = 64, HALF = 128, HTB = HALF * BK * 2  , STAGE_BYTES = 8 * HTB, NXCD = 8, WGM = 8;

__host__ __device__ __forceinline__ int lds_byte(int r, int c) { const int st = (r >> 4) * 2 + (c >> 5), rr = r & 15, cc = c & 31, ob = rr * 64 + cc * 2; return st * 1024 + (ob ^ (((ob >> 9) & 1) << 5)); }
__host__ __device__ __forceinline__ void stage_rc(int b, int& R, int& C) { const int st = b / 1024, sb = b % 1024, swz = sb ^ (((sb >> 9) & 1) << 5); R = (st >> 1) * 16 + swz / 64; C = (st & 1) * 32 + (swz % 64) / 2; }
__host__ __device__ __forceinline__ int perm32(int rho) { const int n = rho >> 4, i = rho & 15; return 8 * (i >> 2) + 4 * n + (i & 3); }

struct Unit { int pm, pn, pz; };
struct Gemm { const bf16_t* A; const bf16_t* Bt; int M, N, K, lda, ldb; };

struct StaticOrder {
    int nM, nN, nwg, G, c;
    __host__ __device__ void init(int M, int N, int G_, int c_) { nM = M / BM; nN = N / BM; nwg = nM * nN; G = G_; c = c_; }
    __host__ __device__ bool next(int i, Unit& u) const {
        const long L = (long)i * G + c; if (L >= nwg) return false;
        int wgid = (int)L; { const int q = nwg / NXCD, r = nwg % NXCD, xcd = wgid % NXCD, off = wgid / NXCD; wgid = (xcd < r ? xcd * (q + 1) : r * (q + 1) + (xcd - r) * q) + off; }
        const int nig = WGM * nN, gid = wgid / nig, fm = gid * WGM, gsz = (nM - fm) < WGM ? (nM - fm) : WGM;
        u.pm = fm + ((wgid % nig) % gsz); u.pn = (wgid % nig) / gsz; u.pz = i; return true;
    }
    __device__ __forceinline__ void a_ready(const Unit&) const {}
    __device__ __forceinline__ void done(const Unit&) const {}
    __device__ __forceinline__ size_t aoff(const Unit&) const { return 0; }
    __device__ __forceinline__ size_t boff(const Unit&) const { return 0; }
};

__device__ __forceinline__ unsigned cvt_pk_bf16(float lo, float hi) { unsigned r; asm volatile("v_cvt_pk_bf16_f32 %0, %1, %2" : "=v"(r) : "v"(lo), "v"(hi)); return r; }

template <class Epi, class Sched, bool ALIGN_EPI = false, bool SP2 = false>
__device__ __forceinline__ void gemm_phase(PG8_LAS unsigned char* lds, const Gemm g, const Sched& S, const Epi& E, const int tid) {
    const int wid = __builtin_amdgcn_readfirstlane(tid >> 6), lane = tid & 63, wr = wid >> 2, wc = wid & 3, fr = lane & 15, fq = lane >> 4;
    const int K = g.K, nt = K / BK;
    unsigned voffA[2], voffB[2];
#pragma unroll
    for (int i = 0; i < 2; ++i) { int R, C; stage_rc(tid * 16 + i * 8192, R, C); const int Rb = Epi::PERM ? ((R & ~31) + perm32(R & 31)) : R;
        voffA[i] = (unsigned)(R * g.lda + C) * 2u; voffB[i] = (unsigned)(Rb * g.ldb + C) * 2u; }
    const size_t kstep = (size_t)(BK * 2);
    const size_t hstepA = (size_t)HALF * g.lda * 2, hstepB = (size_t)HALF * g.ldb * 2;
    const size_t tstepA = 2 * hstepA, tstepB = 2 * hstepB;
    const unsigned ldsw = (unsigned)wid * 1024u;
    const int aoff = lds_byte(wr * 64 + fr, fq * 8), boff = lds_byte(wc * 32 + fr, fq * 8);
#define PG8_SA(b, h) (((b) * 2 + (h)) * HTB)
#define PG8_SB(b, h) ((4 + (b) * 2 + (h)) * HTB)
#define PG8_STAGE(bufoff, gbase, voff) do { _Pragma("unroll") for (int _i = 0; _i < 2; ++_i) \
        __builtin_amdgcn_global_load_lds((const unsigned*)((const char*)(gbase) + (voff)[_i]), (PG8_LAS unsigned*)(lds + (bufoff) + ldsw + _i * 8192), 16, 0, 0); } while (0)
#define PG8_LDA(dst, b, h) do { _Pragma("unroll") for (int m = 0; m < 4; ++m) _Pragma("unroll") for (int k = 0; k < 2; ++k) dst[m][k] = *(const PG8_LAS bf16x8*)(lds + PG8_SA(b, h) + aoff + m * 2048 + k * 1024); } while (0)
#define PG8_LDB(dst, b, h) do { _Pragma("unroll") for (int n = 0; n < 2; ++n) _Pragma("unroll") for (int k = 0; k < 2; ++k) dst[n][k] = *(const PG8_LAS bf16x8*)(lds + PG8_SB(b, h) + boff + n * 2048 + k * 1024); } while (0)
#define PG8_MMA(ai, bj, At, Bt) do { __builtin_amdgcn_s_setprio(1); _Pragma("unroll") for (int m = 0; m < 4; ++m) _Pragma("unroll") for (int n = 0; n < 2; ++n) _Pragma("unroll") for (int k = 0; k < 2; ++k) \
        acc[ai][bj][m][n] = __builtin_amdgcn_mfma_f32_16x16x32_bf16(Bt[n][k], At[m][k], acc[ai][bj][m][n], 0, 0, 0); __builtin_amdgcn_s_setprio(0); } while (0)
#define PG8_WAIT_V(n) asm volatile("s_waitcnt vmcnt(" #n ")" ::: "memory")
#define PG8_WAIT_L(n) asm volatile("s_waitcnt lgkmcnt(" #n ")" ::: "memory")
#define PG8_BAR __builtin_amdgcn_s_barrier()
#define PG8_SCHED __builtin_amdgcn_sched_barrier(0)
    Unit cur, nxt; int ui = 0; const float zf_ = ozero();
    if (!S.next(0, cur)) return;
    f32x4 acc[2][2][4][2];
#pragma unroll
    for (int a = 0; a < 2; ++a)
#pragma unroll
        for (int b = 0; b < 2; ++b)
#pragma unroll
            for (int m = 0; m < 4; ++m)
#pragma unroll
                for (int n = 0; n < 2; ++n) acc[a][b][m][n] = (f32x4){zf_, zf_, zf_, zf_};
    bf16x8 At[4][2], B0[2][2], B1[2][2];
    const char* cA = (const char*)g.A + (size_t)cur.pm * tstepA + S.aoff(cur); const char* cB = (const char*)g.Bt + (size_t)cur.pn * tstepB + S.boff(cur);
    S.a_ready(cur);
    if constexpr (SP2) {
        PG8_STAGE(PG8_SB(0, 0), cB, voffB); PG8_STAGE(PG8_SB(0, 1), cB + hstepB, voffB); PG8_STAGE(PG8_SA(0, 0), cA, voffA); PG8_STAGE(PG8_SA(0, 1), cA + hstepA, voffA);
        if (wr == 1) PG8_BAR;
        PG8_WAIT_V(2); PG8_BAR;
        PG8_STAGE(PG8_SB(1, 0), cB + kstep, voffB); PG8_STAGE(PG8_SA(1, 0), cA + kstep, voffA); PG8_STAGE(PG8_SB(1, 1), cB + hstepB + kstep, voffB);
        PG8_WAIT_V(6); PG8_BAR;
    } else {
        PG8_STAGE(PG8_SB(0, 0), cB, voffB); PG8_STAGE(PG8_SA(0, 0), cA, voffA); PG8_STAGE(PG8_SB(0, 1), cB + hstepB, voffB); PG8_STAGE(PG8_SA(0, 1), cA + hstepA, voffA);
        if (wr == 1) PG8_BAR;
        PG8_WAIT_V(4); PG8_BAR;
        PG8_STAGE(PG8_SB(1, 0), cB + kstep, voffB); PG8_STAGE(PG8_SA(1, 0), cA + kstep, voffA); PG8_STAGE(PG8_SB(1, 1), cB + hstepB + kstep, voffB);
        PG8_WAIT_V(6); PG8_BAR;
    }
    for (;;) {
        const bool has_next = S.next(ui + 1, nxt);
        const char* nA = has_next ? (const char*)g.A + (size_t)nxt.pm * tstepA + S.aoff(nxt) : cA; const char* nB = has_next ? (const char*)g.Bt + (size_t)nxt.pn * tstepB + S.boff(nxt) : cB;
        for (int t = 0; t < nt; t += 2) {
            const bool last = (t == nt - 2);
            const char* a1 = cA + (size_t)(t + 1) * kstep;
            const char* a2 = last ? nA : cA + (size_t)(t + 2) * kstep; const char* b2 = last ? nB : cB + (size_t)(t + 2) * kstep;
            const char* a3 = a2 + kstep; const char* b3 = b2 + kstep;
            if (last && has_next) S.a_ready(nxt);
            if constexpr (SP2) {
            PG8_LDB(B0, 0, 0); PG8_LDB(B1, 0, 1); PG8_SCHED; PG8_LDA(At, 0, 0); PG8_STAGE(PG8_SA(1, 1), a1 + hstepA, voffA);
            PG8_WAIT_V(8); PG8_WAIT_L(0); PG8_BAR; PG8_MMA(0, 0, At, B0); PG8_MMA(0, 1, At, B1); PG8_BAR; PG8_SCHED;
            PG8_LDA(At, 0, 1); PG8_STAGE(PG8_SB(0, 0), b2, voffB); PG8_STAGE(PG8_SB(0, 1), b2 + hstepB, voffB); PG8_STAGE(PG8_SA(0, 0), a2, voffA);
            PG8_WAIT_V(8); PG8_WAIT_L(0); PG8_BAR; PG8_MMA(1, 0, At, B0); PG8_MMA(1, 1, At, B1); PG8_BAR; PG8_SCHED;
            PG8_LDB(B0, 1, 0); PG8_LDB(B1, 1, 1); PG8_SCHED; PG8_LDA(At, 1, 0); PG8_STAGE(PG8_SA(0, 1), a2 + hstepA, voffA);
            PG8_WAIT_V(8); PG8_WAIT_L(0); PG8_BAR; PG8_MMA(0, 0, At, B0); PG8_MMA(0, 1, At, B1); PG8_BAR; PG8_SCHED;
            PG8_LDA(At, 1, 1); PG8_STAGE(PG8_SB(1, 0), b3, voffB); PG8_STAGE(PG8_SB(1, 1), b3 + hstepB, voffB); PG8_STAGE(PG8_SA(1, 0), a3, voffA);
            PG8_WAIT_V(8); PG8_WAIT_L(0); PG8_BAR; PG8_MMA(1, 0, At, B0); PG8_MMA(1, 1, At, B1); PG8_BAR; PG8_SCHED;
            } else {
            PG8_LDB(B0, 0, 0); PG8_SCHED; PG8_LDA(At, 0, 0); PG8_STAGE(PG8_SA(1, 1), a1 + hstepA, voffA);
            PG8_WAIT_L(8); PG8_BAR; PG8_WAIT_L(0); PG8_MMA(0, 0, At, B0); PG8_BAR; PG8_SCHED;
            PG8_LDB(B1, 0, 1); PG8_STAGE(PG8_SB(0, 0), b2, voffB);
            PG8_BAR; PG8_WAIT_L(0); PG8_MMA(0, 1, At, B1); PG8_BAR;
            PG8_LDA(At, 0, 1); PG8_STAGE(PG8_SA(0, 0), a2, voffA);
            PG8_BAR; PG8_WAIT_L(0); PG8_MMA(1, 0, At, B0); PG8_BAR; PG8_SCHED;
            PG8_STAGE(PG8_SB(0, 1), b2 + hstepB, voffB);
            PG8_WAIT_V(6); PG8_BAR; PG8_MMA(1, 1, At, B1); PG8_BAR;
            PG8_LDB(B0, 1, 0); PG8_SCHED; PG8_LDA(At, 1, 0); PG8_STAGE(PG8_SA(0, 1), a2 + hstepA, voffA);
            PG8_WAIT_L(8); PG8_BAR; PG8_WAIT_L(0); PG8_MMA(0, 0, At, B0); PG8_BAR; PG8_SCHED;
            PG8_LDB(B1, 1, 1); PG8_STAGE(PG8_SB(1, 0), b3, voffB);
            PG8_BAR; PG8_WAIT_L(0); PG8_MMA(0, 1, At, B1); PG8_BAR;
            PG8_LDA(At, 1, 1); PG8_STAGE(PG8_SA(1, 0), a3, voffA);
            PG8_BAR; PG8_WAIT_L(0); PG8_MMA(1, 0, At, B0); PG8_BAR; PG8_SCHED;
            PG8_STAGE(PG8_SB(1, 1), b3 + hstepB, voffB);
            PG8_WAIT_V(6); PG8_BAR; PG8_MMA(1, 1, At, B1); PG8_BAR;
            }
        }
        if constexpr (ALIGN_EPI) { if (wr == 0) PG8_BAR; }
        if constexpr (!Epi::AFTER_DRAIN) { E(acc, cur, wr, wc, fr, fq); S.done(cur); }
        if (!has_next) break;
#pragma unroll
        for (int a = 0; a < 2; ++a)
#pragma unroll
            for (int b = 0; b < 2; ++b)
#pragma unroll
                for (int m = 0; m < 4; ++m)
#pragma unroll
                    for (int n = 0; n < 2; ++n) acc[a][b][m][n] = (f32x4){zf_, zf_, zf_, zf_};
        cur = nxt; cA = nA; cB = nB; ++ui;
        if constexpr (ALIGN_EPI) { if (wr == 1) PG8_BAR; }
    }
    PG8_WAIT_V(0);
    if constexpr (!ALIGN_EPI) { if (wr == 0) PG8_BAR; }
    PG8_BAR;
    if constexpr (Epi::AFTER_DRAIN) { E.fused(acc, cur, wr, wc, fr, fq, lds, wid, lane); S.done(cur); }
#undef PG8_SA
#undef PG8_SB
#undef PG8_STAGE
#undef PG8_LDA
#undef PG8_LDB
#undef PG8_MMA
#undef PG8_WAIT_V
#undef PG8_WAIT_L
#undef PG8_BAR
#undef PG8_SCHED
}
}

namespace fa {
constexpr int D = 128; constexpr float THR = 8.f; constexpr bool WSKIP = false;
constexpr float SCALE = 0.08838834764831845f;
constexpr int NW = 8, QBLK = 32, KVBLK = 64, QB = NW * QBLK;
constexpr int SHM_V = KVBLK * D * 2, SHM_K = KVBLK * D * 2;
constexpr int FA_LDS_BYTES = 2 * SHM_V + 2 * SHM_K + NW * 64 * 4;

using bf16 = __hip_bfloat16;
typedef short bf16x8 __attribute__((ext_vector_type(8)));
typedef short s16x4 __attribute__((ext_vector_type(4)));
typedef float f32x16 __attribute__((ext_vector_type(16)));
typedef float f32x4 __attribute__((ext_vector_type(4)));
typedef unsigned u32x4 __attribute__((ext_vector_type(4)));
template <class A, class Bt> struct same_t { static constexpr bool v = false; };
template <class A> struct same_t<A, A> { static constexpr bool v = true; };

#define KSWZ(row, colB) ((row) * 256 + ((colB) ^ (((row) & 7) << 4)))
#define SBAR() __builtin_amdgcn_sched_barrier(0)
__device__ __forceinline__ int v_st(int k, int c) { const int kk = (k & ~0xC) | ((k & 4) << 1) | ((k & 8) >> 1); return ((kk >> 3) * 4 + (c >> 5)) * 512 + ((kk & 7) * 32 + (c & 31)) * 2; }
__device__ __forceinline__ int v_rd_base(int lane) { return ((lane & 3) << 3) | (((lane >> 2) & 3) << 6) | (((lane >> 4) & 1) << 5) | (((lane >> 5) & 1) << 8); }
constexpr int v_rd_off(int d0, int ks, int half) { return d0 * 512 + ks * 4096 + half * 2048; }
__device__ __forceinline__ int crow(int r, int hi) { return (r & 3) + 8 * (r >> 2) + 4 * hi; }
__device__ __forceinline__ unsigned cvtpk(float lo, float hi) {
    unsigned r; asm volatile("v_cvt_pk_bf16_f32 %0, %1, %2" : "=v"(r) : "v"(lo), "v"(hi)); return r;
}
__device__ __forceinline__ bf16x8 pack8(f32x4 a, f32x4 b) {
    u32x4 w = {cvtpk(a[0], a[1]), cvtpk(a[2], a[3]), cvtpk(b[0], b[1]), cvtpk(b[2], b[3])};
    return *reinterpret_cast<bf16x8*>(&w);
}
template <class T> __device__ __forceinline__ bf16x8 load8(const T* p) {
    if constexpr (same_t<T, float>::v) { return pack8(*(const f32x4*)p, *(const f32x4*)(p + 4)); }
    else { return *reinterpret_cast<const bf16x8*>(p); }
}
__device__ __forceinline__ void mask_tile(f32x16& p0, f32x16& p1, int dq, unsigned W) {
    const float NEG = -__builtin_inff();
#pragma unroll
    for (int r = 0; r < 16; ++r) {
        const int c = (r & 3) + 8 * (r >> 2);
        if ((unsigned)(dq - c) >= W) p0[r] = NEG;
        if ((unsigned)(dq - c - 32) >= W) p1[r] = NEG;
    }
}
__device__ __forceinline__ bool rowsel_bit(const u32x4& mw, int T) { const int tw = T >> 5; const unsigned w = tw == 0 ? mw.x : tw == 1 ? mw.y : tw == 2 ? mw.z : mw.w; return ((w >> (T & 31)) & 1u) != 0u; }
__device__ __forceinline__ bool rowsel_upd(unsigned& mwc, const char* lds, int rowidx, int T, bool first) { if ((T & 31) == 0 || first) mwc = ((const unsigned*)(lds + FA_LDS_BYTES))[rowidx * 4 + (T >> 5)]; return ((mwc >> (T & 31)) & 1u) != 0u; }
template <bool HS> __device__ __forceinline__ void partialSM(f32x16& p0, f32x16& p1, float& m_reg, float& mn, float& alpha, bool rs) {
    float pmax = p0[0]; for (int r = 1; r < 16; ++r) pmax = fmaxf(pmax, p0[r]); for (int r = 0; r < 16; ++r) pmax = fmaxf(pmax, p1[r]);
    { auto rr = __builtin_amdgcn_permlane32_swap(__float_as_uint(pmax), __float_as_uint(pmax), false, false);
      pmax = fmaxf(__uint_as_float(rr[0]), __uint_as_float(rr[1])); }
    if (HS && !rs) pmax = -__builtin_inff();
    constexpr float C2 = 1.4426950408889634f * SCALE;
    if (__builtin_expect(__all((pmax - m_reg) * SCALE <= THR), 1)) { mn = m_reg; alpha = 1.f; }
    else { mn = fmaxf(m_reg, pmax); alpha = __builtin_amdgcn_exp2f((m_reg - mn) * C2); m_reg = mn; }
    const float mnL = (HS && !rs) ? -__builtin_inff() : -mn * C2;
    for (int r = 0; r < 16; ++r) p0[r] = fmaf(p0[r], C2, mnL); for (int r = 0; r < 16; ++r) p1[r] = fmaf(p1[r], C2, mnL);
    for (int r = 0; r < 16; ++r) p0[r] = __builtin_amdgcn_exp2f(p0[r]);
}
__device__ __forceinline__ void finishSM(f32x16& p0, f32x16& p1, float alpha, float& l_reg, bf16x8& pa0, bf16x8& pa1, bf16x8& pa2, bf16x8& pa3) {
    for (int r = 0; r < 16; ++r) p1[r] = __builtin_amdgcn_exp2f(p1[r]);
    float ps = 0; for (int r = 0; r < 16; ++r) ps += p0[r]; for (int r = 0; r < 16; ++r) ps += p1[r];
    { auto rr = __builtin_amdgcn_permlane32_swap(__float_as_uint(ps), __float_as_uint(ps), false, false);
      ps = __uint_as_float(rr[0]) + __uint_as_float(rr[1]); }
    l_reg = l_reg * alpha + ps;
#define PK4(P, B_, OUT) do { unsigned a0 = cvtpk(P[B_+0], P[B_+1]), a1 = cvtpk(P[B_+2], P[B_+3]);                          \
        unsigned b0 = cvtpk(P[B_+4], P[B_+5]), b1 = cvtpk(P[B_+6], P[B_+7]);                                             \
        auto r0 = __builtin_amdgcn_permlane32_swap(a0, b0, false, false); auto r1 = __builtin_amdgcn_permlane32_swap(a1, b1, false, false); \
        u32x4 w = {r0[0], r1[0], r0[1], r1[1]}; OUT = *reinterpret_cast<bf16x8*>(&w); } while (0)
    PK4(p0, 0, pa0); PK4(p0, 8, pa1); PK4(p1, 0, pa2); PK4(p1, 8, pa3);
#undef PK4
}
template <int KB, bool SK, int ND = 8>
__device__ __forceinline__ void qkt(f32x16& p0, f32x16& p1, const char* K_lds, int r32, int hi, const bf16x8* qr, bool act) {
    if (SK && !act) { const float NEG = -__builtin_inff();
#pragma unroll
        for (int r = 0; r < 16; ++r) { p0[r] = NEG; p1[r] = NEG; } return; }
    p0 = f32x16{}; p1 = f32x16{};
    const char* kb[4];
#pragma unroll
    for (int dd = 0; dd < 4; ++dd) kb[dd] = K_lds + KB * SHM_K + KSWZ(r32, (dd * 16 + hi * 8) * 2);
#pragma unroll
    for (int d0 = 0; d0 < ND; ++d0) { const char* a = kb[d0 & 3] + (d0 >> 2) * 128;
        bf16x8 b0 = *reinterpret_cast<const bf16x8*>(a);
        bf16x8 b1 = *reinterpret_cast<const bf16x8*>(a + 32 * 256);
        p0 = __builtin_amdgcn_mfma_f32_32x32x16_bf16(b0, qr[d0], p0, 0, 0, 0);
        p1 = __builtin_amdgcn_mfma_f32_32x32x16_bf16(b1, qr[d0], p1, 0, 0, 0); }
}
template <int VB, bool SK>
__device__ __forceinline__ void pv_tile(f32x16* o, int vb0, bf16x8 pa0, bf16x8 pa1, bf16x8 pa2, bf16x8 pa3, bool act) {
    if (SK && !act) return;
#define TRRD(dst, off) asm volatile("ds_read_b64_tr_b16 %0, %1 offset:%2" : "=&v"(dst) : "v"(vb0), "i"(off) : "memory")
#define PV_D0(d0) do { s16x4 l0, l1, l2, l3, h0, h1, h2, h3; constexpr int b_ = VB * SHM_V + v_rd_off(d0, 0, 0);     \
        TRRD(l0, b_); TRRD(h0, b_ + 2048); TRRD(l1, b_ + 4096); TRRD(h1, b_ + 6144); TRRD(l2, b_ + 8192); TRRD(h2, b_ + 10240); TRRD(l3, b_ + 12288); TRRD(h3, b_ + 14336); \
        asm volatile("s_waitcnt lgkmcnt(0)" ::: "memory"); SBAR();                 \
        o[d0] = __builtin_amdgcn_mfma_f32_32x32x16_bf16(pa0, (bf16x8){l0[0], l0[1], l0[2], l0[3], h0[0], h0[1], h0[2], h0[3]}, o[d0], 0, 0, 0);   \
        o[d0] = __builtin_amdgcn_mfma_f32_32x32x16_bf16(pa1, (bf16x8){l1[0], l1[1], l1[2], l1[3], h1[0], h1[1], h1[2], h1[3]}, o[d0], 0, 0, 0);   \
        o[d0] = __builtin_amdgcn_mfma_f32_32x32x16_bf16(pa2, (bf16x8){l2[0], l2[1], l2[2], l2[3], h2[0], h2[1], h2[2], h2[3]}, o[d0], 0, 0, 0);   \
        o[d0] = __builtin_amdgcn_mfma_f32_32x32x16_bf16(pa3, (bf16x8){l3[0], l3[1], l3[2], l3[3], h3[0], h3[1], h3[2], h3[3]}, o[d0], 0, 0, 0); } while (0)
    PV_D0(0); PV_D0(1); PV_D0(2); PV_D0(3);
#undef PV_D0
#undef TRRD
}

template <class TIn, class TOut> struct BlockRef { const TIn* Q; const TIn* K; const TIn* V; TOut* O; int P0, W, jlo, jhi, psub, psh; const u32x4* sel; float2* stats; };
template <class TIn> struct Seam {
    bf16x8 qr[8];
    bf16x8 st_v0, st_v1, st_k0, st_k1; f32x4 sf0, sf1, sf2, sf3;
    f32x4 tq[16];
};
__device__ __forceinline__ int swa_jlo(int P0, int W) { const int lowk = P0 - W + 1; return lowk > 0 ? lowk / KVBLK : 0; }
#define ROW(p, k0, rr) ((p) + (size_t)((k0) + (rr)) * D + sc)
#define VMW() asm volatile("s_waitcnt vmcnt(0)" ::: "memory")
#define VMWN(n) asm volatile("s_waitcnt vmcnt(%0)" :: "i"(n) : "memory")
#define SLOAD_H(Kp, Vp, k0) do { S.st_v0 = load8<TIn>(ROW(Vp, k0, sr)); S.st_v1 = load8<TIn>(ROW(Vp, k0, 32 + sr));              \
                         S.st_k0 = load8<TIn>(ROW(Kp, k0, sr)); S.st_k1 = load8<TIn>(ROW(Kp, k0, 32 + sr)); } while (0)
#define SWRITE_HK(bf) do { *(bf16x8*)(K_lds + (bf) * SHM_K + kws) = S.st_k0; *(bf16x8*)(K_lds + (bf) * SHM_K + kws + 32 * 256) = S.st_k1; } while (0)
#define SWRITE_HV(bf) do { *(bf16x8*)(V_lds + (bf) * SHM_V + vst0) = S.st_v0; *(bf16x8*)(V_lds + (bf) * SHM_V + vst1) = S.st_v1; } while (0)
#define SWRITE_H(bf) do { SWRITE_HV(bf); SWRITE_HK(bf); } while (0)
#define SLOAD_F(p, k0) do { S.sf0 = *(const f32x4*)ROW(p, k0, sr); S.sf1 = *(const f32x4*)(ROW(p, k0, sr) + 4);                \
                            S.sf2 = *(const f32x4*)ROW(p, k0, 32 + sr); S.sf3 = *(const f32x4*)(ROW(p, k0, 32 + sr) + 4); } while (0)
#define SWRITE_KF(bf) do { *(bf16x8*)(K_lds + (bf) * SHM_K + kws) = pack8(S.sf0, S.sf1); *(bf16x8*)(K_lds + (bf) * SHM_K + kws + 32 * 256) = pack8(S.sf2, S.sf3); } while (0)
#define SWRITE_VF(bf) do { *(bf16x8*)(V_lds + (bf) * SHM_V + vst0) = pack8(S.sf0, S.sf1); *(bf16x8*)(V_lds + (bf) * SHM_V + vst1) = pack8(S.sf2, S.sf3); } while (0)
template <class TIn, class TOut>
__device__ __forceinline__ void causal_swa_prime(const BlockRef<TIn, TOut>& cur, char* lds, Seam<TIn>& S, const int tid_in) {
    int tid = tid_in; asm volatile("" : "+v"(tid));
    constexpr bool F32 = same_t<TIn, float>::v;
    const int wid = __builtin_amdgcn_readfirstlane(tid >> 6), lane = tid & 63, r32 = lane & 31, hi = lane >> 5;
    const int sr = tid >> 4, sc = (tid & 15) * 8, kws = KSWZ(sr, sc * 2); char* K_lds = lds + 2 * SHM_V;
    const int kb0 = cur.jlo * KVBLK;
    for (int d0 = 0; d0 < 8; ++d0) S.qr[d0] = load8<TIn>(cur.Q + (size_t)(wid * QBLK + r32) * D + d0 * 16 + hi * 8);
    if constexpr (F32) { SLOAD_F((const float*)cur.K, kb0); VMW(); SWRITE_KF(0); SBAR(); SLOAD_F((const float*)cur.V, kb0); }
    else { SLOAD_H(cur.K, cur.V, kb0); VMW(); SWRITE_HK(0); }
    __syncthreads();
}
template <class TIn, class TOut, bool HS, class NextFn, int ND = 8>
__device__ __forceinline__ void causal_swa_block(const BlockRef<TIn, TOut>& cur, const NextFn& nf, char* lds, Seam<TIn>& S, const int tid_in) {
    int tid = tid_in; asm volatile("" : "+v"(tid));
    constexpr bool F32 = same_t<TIn, float>::v;
    const int wid = __builtin_amdgcn_readfirstlane(tid >> 6), lane = tid & 63, r32 = lane & 31, hi = lane >> 5;
    const int j_lo = cur.jlo, W = cur.W;
    const int j_hi = cur.jhi;
    const int NT = j_hi - j_lo;
    const int qlo = (cur.P0 + wid * QBLK - cur.psub) >> cur.psh, qm = ((cur.P0 + wid * QBLK + r32 - cur.psub) >> cur.psh) - 4 * hi;
    if (HS) { if (hi == 0) *(u32x4*)(lds + FA_LDS_BYTES + (wid * QBLK + r32) * 16) = cur.sel[wid * QBLK + r32]; }
    unsigned mwc = 0u;
#define ROWSEL(t) (HS ? rowsel_upd(mwc, lds, wid * QBLK + r32, j_lo + (t), (t) == 0) : true)
    char* V_lds = lds; char* K_lds = lds + 2 * SHM_V;
    float* ws = (float*)(lds + 2 * SHM_V + 2 * SHM_K) + wid * 64; float* li_l = ws, * al_l = ws + 32;
    float m_reg = -1e30f, l_reg = 0; f32x16 o[4] = {};
    const int sr = tid >> 4, sc = (tid & 15) * 8, vst0 = v_st(sr, sc), vst1 = v_st(32 + sr, sc), kws = KSWZ(sr, sc * 2);
    const int vb0 = (int)(uintptr_t)V_lds + v_rd_base(lane);
    const TIn* Kh = cur.K; const TIn* Vh = cur.V;
#define RESC(a) do { if (__any((a) < 1.f)) { if (hi == 0) al_l[r32] = (a); asm volatile("s_waitcnt lgkmcnt(0)" ::: "memory");              \
                     for (int d_ = 0; d_ < 4; ++d_) for (int r = 0; r < 16; ++r) o[d_][r] *= al_l[crow(r, hi)]; } } while (0)
#define KBASE(t) ((j_lo + (t)) * KVBLK)
#define ACT(t) (KBASE(t) <= qlo + QBLK - 1 && KBASE(t) + KVBLK - 1 >= qlo - W + 1)
#define MASKT(P0_, P1_, t) do { const int kb_ = KBASE(t); if ((!SK || ACT(t)) && (kb_ + KVBLK - 1 > qlo || kb_ <= qlo + QBLK - 1 - W)) mask_tile(P0_, P1_, qm - kb_, (unsigned)W); } while (0)
    constexpr int NQL = F32 ? 16 : 8;
    constexpr bool SK = WSKIP && !F32;
#define SEAM_K0() do { VMWN(NQL); if constexpr (F32) { SWRITE_KF(0); SBAR(); SLOAD_F((const float*)nxt.V, kbn); } else { SWRITE_HK(0); } SBAR(); } while (0)
    f32x16 pA0, pA1, pB0, pB1; float mnA, mnB, alA, alB; bf16x8 pa0, pa1, pa2, pa3;
    if constexpr (F32) { VMW(); SWRITE_VF(0); SBAR(); } else { SWRITE_HV(0); SBAR(); }
    if (NT > 1) { if constexpr (F32) SLOAD_F((const float*)Kh, KBASE(1)); else SLOAD_H(Kh, Vh, KBASE(1)); }
    SBAR(); qkt<0, SK, ND>(pA0, pA1, K_lds, r32, hi, S.qr, ACT(0));
    if constexpr (F32) { if (NT > 1) { VMW(); SWRITE_KF(1); SBAR(); SLOAD_F((const float*)Vh, KBASE(1)); } }
    MASKT(pA0, pA1, 0); partialSM<HS>(pA0, pA1, m_reg, mnA, alA, ROWSEL(0));
    if (NT > 1) { VMW(); if constexpr (F32) { SWRITE_VF(1); SBAR(); if (NT > 2) SLOAD_F((const float*)Kh, KBASE(2)); } else SWRITE_H(1); }
    __syncthreads();
#define HALF_STEP(PX0, PX1, mnX, alX, PY0, PY1, alY, t, KB, VB, SB) do {                                                      \
        SBAR(); qkt<KB, SK, ND>(PX0, PX1, K_lds, r32, hi, S.qr, ACT(t));                                             \
        finishSM(PY0, PY1, alY, l_reg, pa0, pa1, pa2, pa3); SBAR();                                                           \
        if ((t) + 1 < NT) { if constexpr (F32) { VMW(); SWRITE_KF(SB); SBAR(); SLOAD_F((const float*)Vh, KBASE((t) + 1)); }  \
                            else { SLOAD_H(Kh, Vh, KBASE((t) + 1)); } SBAR(); }                                               \
        pv_tile<VB, SK>(o, vb0, pa0, pa1, pa2, pa3, ACT((t) - 1)); MASKT(PX0, PX1, (t)); partialSM<HS>(PX0, PX1, m_reg, mnX, alX, ROWSEL(t));                                        \
        __syncthreads();                                                                                                      \
        if ((t) + 1 < NT) { VMW(); if constexpr (F32) { SWRITE_VF(SB); SBAR(); if ((t) + 2 < NT) SLOAD_F((const float*)Kh, KBASE((t) + 2)); } \
                            else { SWRITE_H(SB); } }                                                                          \
        RESC(alX); __syncthreads(); } while (0)
    for (int t = 1; t + 1 < NT; t += 2) {
        HALF_STEP(pB0, pB1, mnB, alB, pA0, pA1, alA, t, 1, 0, 0);
        HALF_STEP(pA0, pA1, mnA, alA, pB0, pB1, alB, t + 1, 0, 1, 1);
    }
    const bool even = (NT & 1) == 0;
    if (even) { SBAR(); qkt<1, SK, ND>(pB0, pB1, K_lds, r32, hi, S.qr, ACT(NT - 1)); SBAR(); }
    const BlockRef<TIn, TOut> nxt = nf(cur); const int kbn = nxt.jlo * KVBLK;
#define QROW(e) (nxt.Q + (size_t)(wid * QBLK + r32) * D + ((e) >> 1) * 16 + hi * 8 + ((e) & 1) * 4)
    if constexpr (F32) { SLOAD_F((const float*)nxt.K, kbn); SBAR();
#pragma unroll
        for (int e = 0; e < 8; ++e) S.tq[e] = *(const f32x4*)QROW(e); }
    else { SLOAD_H(nxt.K, nxt.V, kbn); SBAR();
#pragma unroll
        for (int d0 = 0; d0 < 8; ++d0) S.qr[d0] = load8<TIn>(nxt.Q + (size_t)(wid * QBLK + r32) * D + d0 * 16 + hi * 8); }
    SBAR();
    finishSM(pA0, pA1, alA, l_reg, pa0, pa1, pa2, pa3); SBAR();
    if constexpr (F32) {
#pragma unroll
        for (int e = 8; e < 16; ++e) S.tq[e] = *(const f32x4*)QROW(e); SBAR(); }
#undef QROW
    pv_tile<0, SK>(o, vb0, pa0, pa1, pa2, pa3, ACT(even ? NT - 2 : NT - 1));
    if (even) { MASKT(pB0, pB1, NT - 1); partialSM<HS>(pB0, pB1, m_reg, mnB, alB, ROWSEL(NT - 1)); __syncthreads(); RESC(alB);
        finishSM(pB0, pB1, alB, l_reg, pa0, pa1, pa2, pa3); SBAR(); pv_tile<1, SK>(o, vb0, pa0, pa1, pa2, pa3, ACT(NT - 1)); }
    SBAR(); SEAM_K0();
    if (hi == 0) li_l[r32] = l_reg; asm volatile("s_waitcnt lgkmcnt(0)" ::: "memory");
    float rli[16];
#pragma unroll
    for (int r = 0; r < 16; ++r) { const float lv_ = li_l[crow(r, hi)]; rli[r] = lv_ > 0.f ? __builtin_amdgcn_rcpf(lv_) : 0.f; }
    if (cur.stats != nullptr && hi == 0) cur.stats[wid * QBLK + r32] = make_float2(m_reg, l_reg);
    TOut* Ow = cur.O + (size_t)(wid * QBLK) * D;
#pragma unroll
    for (int r = 0; r < 16; ++r) { const int orow = crow(r, hi);
#pragma unroll
        for (int d0 = 0; d0 < 4; ++d0) { const float v = o[d0][r] * rli[r];
            if constexpr (same_t<TOut, float>::v) { Ow[(size_t)orow * D + d0 * 32 + r32] = v; }
            else { const float vn = __shfl_xor(v, 1);
                   if ((r32 & 1) == 0) *(unsigned*)(Ow + (size_t)orow * D + d0 * 32 + r32) = cvtpk(v, vn); } } }
    if constexpr (F32) {
#pragma unroll
        for (int d0 = 0; d0 < 8; ++d0) S.qr[d0] = pack8(S.tq[2 * d0], S.tq[2 * d0 + 1]); }
    __syncthreads();
#undef RESC
#undef ROWSEL
#undef KBASE
#undef ACT
#undef MASKT
#undef SEAM_K0
#undef HALF_STEP
}
#undef ROW
#undef VMW
#undef VMWN
#undef SLOAD_H
#undef SWRITE_HK
#undef SWRITE_HV
#undef SWRITE_H
#undef SLOAD_F
#undef SWRITE_KF
#undef SWRITE_VF

}
#define GAS __attribute__((address_space(1)))
#define RLX_AGENT __ATOMIC_RELAXED, __HIP_MEMORY_SCOPE_AGENT
#define LAS __attribute__((address_space(3)))
#define XB_TMO      128
#define XB_XCNT(j)  (256  + 64 * (j))
#define XB_XSUB(j)  (1280 + 64 * (j))
#define XB_XGEN(j)  (2304 + 64 * (j))
#define XB_TOP      3328
#define XB_TOPGEN   3392
#define XCD_BAR_WORDS 3456
#define XB_SPIN_CAP (1u << 18)

__device__ __forceinline__ unsigned xb_ld(unsigned* p)              { return __hip_atomic_load(p, __ATOMIC_RELAXED, __HIP_MEMORY_SCOPE_AGENT); }
__device__ __forceinline__ unsigned xb_add(unsigned* p, unsigned v) { return __hip_atomic_fetch_add(p, v, __ATOMIC_RELAXED, __HIP_MEMORY_SCOPE_AGENT); }
__device__ __forceinline__ unsigned xb_xcc_id() { return (unsigned)__builtin_amdgcn_s_getreg((3 << 11) | 20) & 0xFu; }
#define XB_SPIN(cond, bar) do { unsigned _sp = 0; while (cond) { __builtin_amdgcn_s_sleep(1); \
    if ((++_sp & 255u) == 0u) { if (xb_ld(&(bar)[XB_TMO])) break; if (_sp > XB_SPIN_CAP) { atomicAdd(&(bar)[XB_TMO], 1u); break; } } } } while (0)

struct XcdBarrier {
    unsigned* bar; unsigned x;
    volatile LAS unsigned* st;
};

__device__ __forceinline__ XcdBarrier xcd_barrier_post(unsigned* bar, volatile LAS unsigned* st, const bool t0) {
    XcdBarrier b; b.bar = bar; b.x = xb_xcc_id(); b.st = st;
    if (t0) (void)xb_add(&bar[XB_XCNT(b.x)], 1u);
    return b;
}
__device__ __forceinline__ void xcd_barrier_complete(unsigned* bar, unsigned x, unsigned& nloc, unsigned& nx) {
    const unsigned G = gridDim.x * gridDim.y * gridDim.z;
    unsigned sum, cnt, mine, sp = 0u;
    for (;;) {
        sum = 0u; cnt = 0u; mine = 0u;
#pragma unroll
        for (unsigned j = 0; j < 16; ++j) { const unsigned c = xb_ld(&bar[XB_XCNT(j)]); sum += c; cnt += (c > 0u) ? 1u : 0u; mine = (j == x) ? c : mine; }
        if (sum == G) break;
        __builtin_amdgcn_s_sleep(1);
        if ((++sp & 255u) == 0u) { if (xb_ld(&bar[XB_TMO])) break; if (sp > XB_SPIN_CAP) { atomicAdd(&bar[XB_TMO], 1u); break; } }
    }
    nloc = mine > 0u ? mine : 1u; nx = cnt > 0u ? cnt : 1u;
}

__device__ __forceinline__ void xcd_barrier(const XcdBarrier& b, const bool t0) {
    asm volatile("s_waitcnt vmcnt(0)" ::: "memory");
    __syncthreads();
    if (t0) {
        unsigned* bar = b.bar;
        __builtin_amdgcn_s_waitcnt(0);
        unsigned nloc = b.st[0], nx = b.st[1];
        if (nloc == 0u) { xcd_barrier_complete(bar, b.x, nloc, nx); b.st[0] = nloc; b.st[1] = nx; }
        const unsigned old = xb_add(&bar[XB_XSUB(b.x)], 1u);
        const unsigned gen = old / nloc;
        if (old + 1u == (gen + 1u) * nloc) {
            __builtin_amdgcn_fence(__ATOMIC_RELEASE, "agent");
            asm volatile("s_waitcnt vmcnt(0)" ::: "memory");
            const unsigned og = xb_add(&bar[XB_TOP], 1u);
            const unsigned tg = og / nx;
            if (og + 1u == (tg + 1u) * nx) xb_add(&bar[XB_TOPGEN], 1u);
            else XB_SPIN(xb_ld(&bar[XB_TOPGEN]) == tg, bar);
            __builtin_amdgcn_fence(__ATOMIC_ACQUIRE, "agent");
            xb_add(&bar[XB_XGEN(b.x)], 1u);
            asm volatile("s_waitcnt vmcnt(0)" ::: "memory");
        } else {
            XB_SPIN(xb_ld(&bar[XB_XGEN(b.x)]) == gen, bar);
            __builtin_amdgcn_fence(__ATOMIC_ACQUIRE, "agent");
            asm volatile("s_waitcnt vmcnt(0)" ::: "memory");
        }
    }
    __syncthreads();
}

typedef unsigned short bf16_t;
typedef float f32x4 __attribute__((ext_vector_type(4)));
typedef float f32x16 __attribute__((ext_vector_type(16)));
typedef short bf16x8 __attribute__((ext_vector_type(8)));
typedef unsigned u32x4 __attribute__((ext_vector_type(4)));
typedef unsigned u32x2 __attribute__((ext_vector_type(2)));

constexpr int S = 8192, DM = 2048, FF = 8192, NIN = 5168, NINP = 5376;
constexpr size_t HS128 = (size_t)S * 128;
constexpr size_t MiB = 1u << 20;
constexpr size_t W_IN_SZ = (size_t)NINP * DM, W_C_SZ = (size_t)2 * 1024 * 2048, W_2_SZ = (size_t)2 * 128 * 512, W_O_SZ = (size_t)DM * DM;
constexpr size_t W_NSA_SZ = W_IN_SZ + W_C_SZ + W_2_SZ + W_O_SZ;
constexpr size_t WOFF_NSA = 0;
constexpr size_t WOFF_QKV = 2 * W_NSA_SZ;
constexpr size_t WOFF_Q3 = WOFF_QKV + (size_t)3072 * DM;
constexpr size_t WOFF_DWO = WOFF_Q3 + (size_t)DM * DM;
constexpr size_t WOFF_UP = WOFF_DWO + 2 * (size_t)DM * DM;
constexpr size_t WOFF_DN = WOFF_UP + 4 * (size_t)FF * DM;
constexpr size_t W_TOTAL = WOFF_DN + 4 * (size_t)FF * DM;
constexpr size_t WS_W = 2 * MiB;
static_assert(WS_W + W_TOTAL * 2 <= 370 * MiB, "weight region");
constexpr size_t WS_X = 372 * MiB, WS_XN = 436 * MiB, WS_O = 468 * MiB, WS_KD = 500 * MiB, WS_VD = 516 * MiB;
constexpr size_t WS_GATES = 524 * MiB, WS_STATS = 526 * MiB, WS_MASK = 527 * MiB, WS_TAB = 528 * MiB, WS_IMP = 530 * MiB;
constexpr size_t WS_R = 546 * MiB;
constexpr size_t WS_SLOT = WS_R, WS_QROT = WS_R + 80 * MiB, WS_PART = WS_R + 112 * MiB, WS_KC2 = WS_R + 176 * MiB;
constexpr size_t WS_OC = WS_R + 178 * MiB, WS_OW = WS_R + 210 * MiB, WS_OS = WS_R + 242 * MiB;
constexpr size_t WS_U = WS_R, WS_QD = WS_R, WS_OD = WS_R + 64 * MiB;
constexpr size_t WS_END = WS_R + 274 * MiB;
constexpr size_t TAB_COSA = 0, TAB_SINA = (size_t)S * 16 * 4, TAB_COSB = 2 * (size_t)S * 16 * 4, TAB_SINB = TAB_COSB + (size_t)S * 8 * 4, TAB_BIASP = TAB_SINB + (size_t)S * 8 * 4;

constexpr size_t WS_ROWSS = 1 * MiB;
constexpr int LDS_RSTD = 131072 + 1024, RSTD_SLOTS = 16;
constexpr int LDS_BYTES = LDS_RSTD + RSTD_SLOTS * 1024;

struct Params { const float* in[17]; float* out; unsigned char* ws; int ph_lo, ph_hi; };
typedef const Params __attribute__((address_space(4))) * KParamsPtr;
__device__ __forceinline__ KParamsPtr lprm() { KParamsPtr p = (KParamsPtr)__builtin_amdgcn_kernarg_segment_ptr(); asm volatile("" : "+s"(p)); return p; }

struct Ctx { unsigned char* ws; char* lds; int tid, lane, wave, G, bid, gw, NGW; };

__device__ __forceinline__ float wave_sum(float v) {
#pragma unroll
    for (int o = 1; o < 64; o <<= 1) v += __shfl_xor(v, o);
    return v;
}
__device__ __forceinline__ unsigned pk2(float lo, float hi) { return pg8::cvt_pk_bf16(lo, hi); }
__device__ __forceinline__ float bf2f(unsigned short b) { return __uint_as_float(((unsigned)b) << 16); }

__device__ __forceinline__ void conv_item(const float* W, int N, int ldw, const float* g, bf16_t* WT, int ldt, int nblk, int item, int lane, LAS unsigned char* scr) {
    const int kb = item / nblk, nb = item % nblk, k0 = 64 * kb, n0 = 64 * nb, n4 = (lane & 15) * 4, kg = lane >> 4;
    const bool ok = (n0 + n4) < N; const float* src = W + (size_t)(k0 + 16 * kg) * ldw + (ok ? n0 + n4 : 0);
    f32x4 v[16];
#pragma unroll
    for (int i = 0; i < 16; ++i) v[i] = __builtin_nontemporal_load((const f32x4*)(src + (size_t)i * ldw));
    if (g) {
#pragma unroll
        for (int i = 0; i < 16; ++i) v[i] = v[i] * g[k0 + 16 * kg + i];
    }
#pragma unroll
    for (int j = 0; j < 4; ++j) { u32x4 o0, o1;
        o0.x = pk2(v[0][j], v[1][j]); o0.y = pk2(v[2][j], v[3][j]); o0.z = pk2(v[4][j], v[5][j]); o0.w = pk2(v[6][j], v[7][j]);
        o1.x = pk2(v[8][j], v[9][j]); o1.y = pk2(v[10][j], v[11][j]); o1.z = pk2(v[12][j], v[13][j]); o1.w = pk2(v[14][j], v[15][j]);
        if (!ok) { o0 = (u32x4){0u, 0u, 0u, 0u}; o1 = o0; }
        *(LAS u32x4*)(scr + (n4 + j) * 144 + 32 * kg) = o0; *(LAS u32x4*)(scr + (n4 + j) * 144 + 32 * kg + 16) = o1; }
    asm volatile("s_waitcnt lgkmcnt(0)" ::: "memory");
#pragma unroll
    for (int i = 0; i < 8; ++i) { const int row = 8 * i + (lane >> 3), ch = lane & 7; const u32x4 o = *(const LAS u32x4*)(scr + row * 144 + ch * 16);
        *(u32x4*)(WT + (size_t)(n0 + row) * ldt + k0 + ch * 8) = o; }
    asm volatile("s_waitcnt lgkmcnt(0)" ::: "memory");
}
__device__ __forceinline__ void conv_matrix(const Ctx& C, const float* W, int K, int N, int NP, int ldw, const float* g, bf16_t* WT, int ldt, int& base) {
    const int nblk = NP / 64, nitems = (K / 64) * nblk; LAS unsigned char* scr = (LAS unsigned char*)C.lds + C.wave * (64 * 144);
    const int first = (C.gw + C.NGW - (base % C.NGW)) % C.NGW;
    for (int it = first; it < nitems; it += C.NGW) conv_item(W, N, ldw, g, WT, ldt, nblk, it, C.lane, scr);
    base += nitems;
}
__device__ __forceinline__ void norm_phase(const Ctx& C, const float* src, float* copy, bf16_t* xn, float* outf, const float* gain) {
    for (int row = C.gw; row < S; row += C.NGW) {
        const f32x4* xr = (const f32x4*)(src + (size_t)row * DM) + C.lane;
        f32x4 v[8]; float ss = 0.f;
#pragma unroll
        for (int j = 0; j < 8; ++j) { v[j] = xr[64 * j]; ss += (v[j].x * v[j].x + v[j].y * v[j].y) + (v[j].z * v[j].z + v[j].w * v[j].w); }
        const float rstd = 1.0f / sqrtf(wave_sum(ss) * (1.0f / DM) + 1e-6f);
        if (copy) { f32x4* cr = (f32x4*)(copy + (size_t)row * DM) + C.lane;
#pragma unroll
            for (int j = 0; j < 8; ++j) cr[64 * j] = v[j]; }
        if (xn) { u32x2* o8 = (u32x2*)(xn + (size_t)row * DM) + C.lane;
#pragma unroll
            for (int j = 0; j < 8; ++j) { u32x2 w; w.x = pk2(v[j].x * rstd, v[j].y * rstd); w.y = pk2(v[j].z * rstd, v[j].w * rstd); o8[64 * j] = w; } }
        if (outf) { f32x4* orow = (f32x4*)(outf + (size_t)row * DM) + C.lane; const f32x4* gr = (const f32x4*)gain + C.lane;
#pragma unroll
            for (int j = 0; j < 8; ++j) { const f32x4 gg = gr[64 * j]; orow[64 * j] = v[j] * rstd * gg; } }
    }
}

__device__ __forceinline__ void xb_phase(const Ctx& C, const float* src, bf16_t* xb, float* rowss) {
    for (int row = C.gw; row < S; row += C.NGW) {
        const f32x4* xr = (const f32x4*)(src + (size_t)row * DM) + C.lane;
        f32x4 v[8]; float ss = 0.f;
#pragma unroll
        for (int j = 0; j < 8; ++j) { v[j] = xr[64 * j]; ss += (v[j].x * v[j].x + v[j].y * v[j].y) + (v[j].z * v[j].z + v[j].w * v[j].w); }
        ss = wave_sum(ss);
        u32x2* o8 = (u32x2*)(xb + (size_t)row * DM) + C.lane;
#pragma unroll
        for (int j = 0; j < 8; ++j) { u32x2 w; w.x = pk2(v[j].x, v[j].y); w.y = pk2(v[j].z, v[j].w); o8[64 * j] = w; }
        if (C.lane < 32) rowss[(size_t)row * 32 + C.lane] = C.lane == 0 ? ss : 0.f;
    }
}
template <class Sched> __device__ __forceinline__ void rstd_prestep(const Ctx& C, const Sched& So, const float* rowss) {
    LAS float* R = (LAS float*)(C.lds + LDS_RSTD);
    pg8::Unit u;
    for (int i = 0; i < RSTD_SLOTS && So.next(i, u); ++i) {
        const int r = C.tid >> 1, hf = C.tid & 1; const float* p = rowss + (size_t)(u.pm * 256 + r) * 32 + hf * 16;
        const f32x4 a = *(const f32x4*)p, b = *(const f32x4*)(p + 4), c = *(const f32x4*)(p + 8), d = *(const f32x4*)(p + 12);
        float ss = ((a.x + a.y) + (a.z + a.w)) + ((b.x + b.y) + (b.z + b.w)) + ((c.x + c.y) + (c.z + c.w)) + ((d.x + d.y) + (d.z + d.w));
        ss += __shfl_xor(ss, 1);
        if (hf == 0) R[i * 256 + r] = 1.0f / sqrtf(ss * (1.0f / DM) + 1e-6f);
    }
    __syncthreads();
}
__device__ __forceinline__ void final_norm_phase(const Ctx& C, const bf16_t* xb, float* outf, const float* gain) {
    for (int row = C.gw; row < S; row += C.NGW) {
        const u32x2* xr = (const u32x2*)(xb + (size_t)row * DM) + C.lane;
        f32x4 v[8]; float ss = 0.f;
#pragma unroll
        for (int j = 0; j < 8; ++j) { const u32x2 w = xr[64 * j]; v[j] = (f32x4){__uint_as_float(w.x << 16), __uint_as_float(w.x & 0xffff0000u), __uint_as_float(w.y << 16), __uint_as_float(w.y & 0xffff0000u)};
            ss += (v[j].x * v[j].x + v[j].y * v[j].y) + (v[j].z * v[j].z + v[j].w * v[j].w); }
        const float rstd = 1.0f / sqrtf(wave_sum(ss) * (1.0f / DM) + 1e-6f);
        f32x4* orow = (f32x4*)(outf + (size_t)row * DM) + C.lane; const f32x4* gr = (const f32x4*)gain + C.lane;
#pragma unroll
        for (int j = 0; j < 8; ++j) { const f32x4 gg = gr[64 * j]; orow[64 * j] = v[j] * rstd * gg; }
    }
}
struct ZSched {
    int nM, nN, nZ, G, c; size_t aJ, aS, bJ, bS;
    __device__ __forceinline__ bool next(int i, pg8::Unit& u) const { const long L = (long)i * G + c; if (L >= (long)nM * nN * nZ) return false;
        const int per = nM * nN; u.pz = (int)(L / per); const int r = (int)(L % per); u.pm = r / nN; u.pn = r % nN; return true; }
    __device__ __forceinline__ void a_ready(const pg8::Unit&) const {}
    __device__ __forceinline__ void done(const pg8::Unit&) const {}
    __device__ __forceinline__ size_t aoff(const pg8::Unit& u) const { return (size_t)(u.pz >> 2) * aJ + (size_t)(u.pz & 3) * aS; }
    __device__ __forceinline__ size_t boff(const pg8::Unit& u) const { return (size_t)(u.pz >> 2) * bJ + (size_t)(u.pz & 3) * bS; }
};
typedef f32x4 AccT[2][2][4][2];
struct EpiIn {
    static constexpr bool PERM = true, AFTER_DRAIN = false;
    bf16_t* slot; bf16_t* qrot; float* gates; const float* cosA; const float* sinA; const LAS float* R;
    __device__ __forceinline__ void operator()(const AccT& acc, const pg8::Unit& u, int wr, int wc, int fr, int fq) const {
        const int row0 = u.pm * 256 + wr * 64 + fr; const LAS float* Ru = R + (u.pz & (RSTD_SLOTS - 1)) * 256 + wr * 64 + fr;
#pragma unroll
        for (int bj = 0; bj < 2; ++bj) {
            const int sl = 2 * u.pn + bj;
            if (sl > 40) continue;
            const int d0 = wc * 32 + 8 * fq;
            if (sl == 40) {
#pragma unroll
                for (int ai = 0; ai < 2; ++ai)
#pragma unroll
                    for (int m = 0; m < 4; ++m) { const int row = row0 + ai * 128 + m * 16; const float rs = Ru[ai * 128 + m * 16]; const f32x4 v0 = acc[ai][bj][m][0] * rs, v1 = acc[ai][bj][m][1] * rs;
#pragma unroll
                        for (int j = 0; j < 8; ++j) { const int c = d0 + j; const float x = j < 4 ? v0[j & 3] : v1[j & 3]; if (c < 48) gates[(size_t)row * 48 + c] = 1.0f / (1.0f + __expf(-x)); } }
                continue;
            }
            const bool isq = sl < 16;
            const bool rot = isq || (sl >= 24 && sl < 28) || (sl >= 32 && sl < 36);
            bf16_t* dst = slot + (size_t)sl * HS128;
            bf16_t* rdst = isq ? qrot + (size_t)sl * HS128 : dst;
#pragma unroll
            for (int ai = 0; ai < 2; ++ai)
#pragma unroll
                for (int m = 0; m < 4; ++m) { const int row = row0 + ai * 128 + m * 16; const float rs = Ru[ai * 128 + m * 16]; f32x4 v0 = acc[ai][bj][m][0] * rs, v1 = acc[ai][bj][m][1] * rs;
                    if (isq || !rot) { u32x4 w; w.x = pk2(v0[0], v0[1]); w.y = pk2(v0[2], v0[3]); w.z = pk2(v1[0], v1[1]); w.w = pk2(v1[2], v1[3]); *(u32x4*)(dst + (size_t)row * 128 + d0) = w; }
                    if (rot) {
                        if (wc == 0) {
                            const int i0 = 8 * (fq & 1);
                            const f32x4 c0 = *(const f32x4*)(cosA + (size_t)row * 16 + i0), c1 = *(const f32x4*)(cosA + (size_t)row * 16 + i0 + 4);
                            const f32x4 s0 = *(const f32x4*)(sinA + (size_t)row * 16 + i0), s1 = *(const f32x4*)(sinA + (size_t)row * 16 + i0 + 4);
                            f32x4 p0, p1;
#pragma unroll
                            for (int j = 0; j < 4; ++j) { p0[j] = __shfl_xor(v0[j], 32); p1[j] = __shfl_xor(v1[j], 32); }
                            const float sg = fq < 2 ? -1.f : 1.f;
                            v0 = v0 * c0 + (p0 * sg) * s0; v1 = v1 * c1 + (p1 * sg) * s1;
                        }
                        u32x4 w; w.x = pk2(v0[0], v0[1]); w.y = pk2(v0[2], v0[3]); w.z = pk2(v1[0], v1[1]); w.w = pk2(v1[2], v1[3]); *(u32x4*)(rdst + (size_t)row * 128 + d0) = w;
                    } }
        }
    }
};
struct EpiQ {
    static constexpr bool PERM = true, AFTER_DRAIN = false;
    bf16_t* qd; bf16_t* kd; bf16_t* vd; const float* cosB; const float* sinB; const LAS float* R;
    __device__ __forceinline__ void operator()(const AccT& acc, const pg8::Unit& u, int wr, int wc, int fr, int fq) const {
        const int row0 = u.pm * 256 + wr * 64 + fr; const LAS float* Ru = R + (u.pz & (RSTD_SLOTS - 1)) * 256 + wr * 64 + fr;
#pragma unroll
        for (int bj = 0; bj < 2; ++bj) {
            const int colh = u.pn * 256 + bj * 128;
            if (colh >= 2560) {
                bf16_t* dst = vd + (size_t)((colh - 2560) >> 7) * HS128; const int d0 = wc * 32 + 8 * fq;
#pragma unroll
                for (int ai = 0; ai < 2; ++ai)
#pragma unroll
                    for (int m = 0; m < 4; ++m) { const int row = row0 + ai * 128 + m * 16; const float rs = Ru[ai * 128 + m * 16]; const f32x4 v0 = acc[ai][bj][m][0] * rs, v1 = acc[ai][bj][m][1] * rs;
                        u32x4 w; w.x = pk2(v0[0], v0[1]); w.y = pk2(v0[2], v0[3]); w.z = pk2(v1[0], v1[1]); w.w = pk2(v1[2], v1[3]); *(u32x4*)(dst + (size_t)row * 128 + d0) = w; }
                continue;
            }
            const bool isq = colh < 2048;
            const int inst = (isq ? colh : colh - 2048) / 64 + (wc >> 1);
            bf16_t* dst = (isq ? qd : kd) + (size_t)inst * HS128;
            const float sc = isq ? 1.41421356237f : 1.0f;
            const int d0 = (wc & 1) * 32 + 8 * fq;
#pragma unroll
            for (int ai = 0; ai < 2; ++ai)
#pragma unroll
                for (int m = 0; m < 4; ++m) { const int row = row0 + ai * 128 + m * 16; const float rs = Ru[ai * 128 + m * 16]; f32x4 v0 = acc[ai][bj][m][0] * rs, v1 = acc[ai][bj][m][1] * rs;
                    if ((wc & 1) == 0) {
                        const f32x4 c0 = *(const f32x4*)(cosB + (size_t)row * 8), c1 = *(const f32x4*)(cosB + (size_t)row * 8 + 4);
                        const f32x4 s0 = *(const f32x4*)(sinB + (size_t)row * 8), s1 = *(const f32x4*)(sinB + (size_t)row * 8 + 4);
                        f32x4 p0, p1;
#pragma unroll
                        for (int j = 0; j < 4; ++j) { p0[j] = __shfl_xor(v0[j], 16); p1[j] = __shfl_xor(v1[j], 16); }
                        if (fq < 2) { const float sg = fq == 0 ? -1.f : 1.f; v0 = v0 * c0 + (p0 * sg) * s0; v1 = v1 * c1 + (p1 * sg) * s1; }
                    }
                    v0 = v0 * sc; v1 = v1 * sc;
                    u32x4 w; w.x = pk2(v0[0], v0[1]); w.y = pk2(v0[2], v0[3]); w.z = pk2(v1[0], v1[1]); w.w = pk2(v1[2], v1[3]);
                    *(u32x4*)(dst + (size_t)row * 128 + d0) = w; }
        }
    }
};
struct EpiUp {
    static constexpr bool PERM = true, AFTER_DRAIN = false;
    bf16_t* U; const LAS float* R;
    __device__ __forceinline__ void operator()(const AccT& acc, const pg8::Unit& u, int wr, int wc, int fr, int fq) const {
        const int row0 = u.pm * 256 + wr * 64 + fr, col0 = u.pn * 256 + wc * 32 + 8 * fq; const LAS float* Ru = R + (u.pz & (RSTD_SLOTS - 1)) * 256 + wr * 64 + fr;
#pragma unroll
        for (int ai = 0; ai < 2; ++ai)
#pragma unroll
            for (int m = 0; m < 4; ++m) { bf16_t* rowp = U + (size_t)(row0 + ai * 128 + m * 16) * FF + col0; const float rs = Ru[ai * 128 + m * 16];
#pragma unroll
                for (int bj = 0; bj < 2; ++bj) { f32x4 v0 = acc[ai][bj][m][0], v1 = acc[ai][bj][m][1];
#pragma unroll
                    for (int j = 0; j < 4; ++j) { const float a = fmaxf(v0[j] * rs, 0.f), b = fmaxf(v1[j] * rs, 0.f); v0[j] = a * a; v1[j] = b * b; }
                    u32x4 w; w.x = pk2(v0[0], v0[1]); w.y = pk2(v0[2], v0[3]); w.z = pk2(v1[0], v1[1]); w.w = pk2(v1[2], v1[3]); *(u32x4*)(rowp + bj * 128) = w; } }
    }
};
struct EpiRes {
    static constexpr bool PERM = false, AFTER_DRAIN = false;
    const float* X0; bf16_t* XB; float* rowss;
    __device__ __forceinline__ void operator()(const AccT& acc, const pg8::Unit& u, int wr, int wc, int fr, int fq) const {
        const int row0 = u.pm * 256 + wr * 64 + fr, col0 = u.pn * 256 + wc * 32 + 4 * fq;
#pragma unroll
        for (int ai = 0; ai < 2; ++ai)
#pragma unroll
            for (int m = 0; m < 4; ++m) { const int row = row0 + ai * 128 + m * 16; const size_t ro = (size_t)row * DM + col0; float ss = 0.f;
#pragma unroll
                for (int bj = 0; bj < 2; ++bj)
#pragma unroll
                    for (int n = 0; n < 2; ++n) { const size_t off = ro + bj * 128 + n * 16; f32x4 v;
                        if (X0) v = *(const f32x4*)(X0 + off);
                        else { const u32x2 w = *(const u32x2*)(XB + off); v = (f32x4){__uint_as_float(w.x << 16), __uint_as_float(w.x & 0xffff0000u), __uint_as_float(w.y << 16), __uint_as_float(w.y & 0xffff0000u)}; }
                        v = v + acc[ai][bj][m][n];
                        u32x2 w; w.x = pk2(v.x, v.y); w.y = pk2(v.z, v.w); *(u32x2*)(XB + off) = w;
                        const float r0 = __uint_as_float(w.x << 16), r1 = __uint_as_float(w.x & 0xffff0000u), r2 = __uint_as_float(w.y << 16), r3 = __uint_as_float(w.y & 0xffff0000u);
                        ss += (r0 * r0 + r1 * r1) + (r2 * r2 + r3 * r3); }
                ss += __shfl_xor(ss, 16); ss += __shfl_xor(ss, 32);
                if (fq == 0) rowss[(size_t)row * 32 + u.pn * 4 + wc] = ss; }
    }
};
struct EpiPart {
    static constexpr bool PERM = false, AFTER_DRAIN = false;
    float* P;
    __device__ __forceinline__ void operator()(const AccT& acc, const pg8::Unit& u, int wr, int wc, int fr, int fq) const {
        const int row0 = u.pm * 256 + wr * 64 + fr, col0 = u.pn * 256 + wc * 32 + 4 * fq;
        float* base = P + (size_t)u.pz * 2048 * 1024;
#pragma unroll
        for (int ai = 0; ai < 2; ++ai)
#pragma unroll
            for (int m = 0; m < 4; ++m) { float* rowp = base + (size_t)(row0 + ai * 128 + m * 16) * 1024 + col0;
#pragma unroll
                for (int bj = 0; bj < 2; ++bj)
#pragma unroll
                    for (int n = 0; n < 2; ++n) *(f32x4*)(rowp + bj * 128 + n * 16) = acc[ai][bj][m][n]; }
    }
};

__device__ __forceinline__ float gelu_tanh(float x) { const float u = 0.7978845608028654f * (x + 0.044715f * x * x * x); const float e = __expf(2.f * u); const float t = 1.f - 2.f / (e + 1.f); return 0.5f * x * (1.f + t); }
__device__ __forceinline__ void cmp2_phase(const Ctx& C, const float* part, const float* biasp, const bf16_t* w2t, bf16_t* kc2) {
    LAS bf16_t* Hs = (LAS bf16_t*)C.lds;
    for (int unit = C.bid; unit < 256; unit += C.G) {
        const int j = unit >> 7, R0 = (unit & 127) * 16;
        bf16x8 bfr[16];
        { const bf16_t* brow_ = w2t + (size_t)j * 128 * 512 + (size_t)(16 * C.wave + (C.lane & 15)) * 512 + 8 * (C.lane >> 4);
#pragma unroll
          for (int kk = 0; kk < 16; ++kk) bfr[kk] = *(const bf16x8*)(brow_ + kk * 32); }
        {   const int r = C.tid >> 5, c0 = (C.tid & 31) * 16; const int R = R0 + r;
            f32x4 a[4];
#pragma unroll
            for (int q = 0; q < 4; ++q) { a[q] = (f32x4){0.f, 0.f, 0.f, 0.f};
#pragma unroll
                for (int kc = 0; kc < 8; ++kc) a[q] = a[q] + *(const f32x4*)(biasp + ((size_t)j * 8 + kc) * 512 + c0 + 4 * q); }
#pragma unroll
            for (int sp = 0; sp < 4; ++sp) { const float* pz = part + (size_t)(j * 4 + sp) * 2048 * 1024;
#pragma unroll
                for (int q = 0; q < 4; ++q) a[q] = a[q] + *(const f32x4*)(pz + (size_t)R * 1024 + c0 + 4 * q) + *(const f32x4*)(pz + (size_t)(R + 1) * 1024 + 512 + c0 + 4 * q); }
#pragma unroll
            for (int q = 0; q < 4; ++q) { u32x2 w; w.x = pk2(gelu_tanh(a[q][0]), gelu_tanh(a[q][1])); w.y = pk2(gelu_tanh(a[q][2]), gelu_tanh(a[q][3])); *(LAS u32x2*)(Hs + r * 520 + c0 + 4 * q) = w; }
        }
        __syncthreads();
        {   const int fr = C.lane & 15, fq = C.lane >> 4; f32x4 acc = {0.f, 0.f, 0.f, 0.f};
            const bf16_t* brow = w2t + (size_t)j * 128 * 512 + (size_t)(16 * C.wave + fr) * 512 + 8 * fq;
#pragma unroll
            for (int kk = 0; kk < 16; ++kk) { const bf16x8 a = *(const LAS bf16x8*)(Hs + fr * 520 + kk * 32 + 8 * fq); const bf16x8 b = bfr[kk];
                acc = __builtin_amdgcn_mfma_f32_16x16x32_bf16(a, b, acc, 0, 0, 0); }
#pragma unroll
            for (int r = 0; r < 4; ++r) { const int R = R0 + fq * 4 + r; float v = acc[r]; if ((R & 511) == 511) v = 0.f;
                const float vn = __shfl_xor(v, 1); if ((fr & 1) == 0) *(unsigned*)(kc2 + (size_t)j * 2048 * 128 + (size_t)R * 128 + 16 * C.wave + fr) = pk2(v, vn); }
        }
        __syncthreads();
    }
}
typedef fa::BlockRef<fa::bf16, fa::bf16> RefB;
typedef fa::BlockRef<fa::bf16, float> RefF;
constexpr int W_CAUSAL = 0x3fffffff;
__device__ __forceinline__ bool refA(const Ctx& C, int q, RefB& r) {
    const int pair = C.bid + (q >> 1) * C.G; if (pair >= 512) return false;
    const bool cmp = pair >= 256; const int pp = pair & 255, h = pp >> 4, p = pp & 15, qb = (q & 1) ? 31 - p : p, hk = h >> 2;
    const bf16_t* slot = (const bf16_t*)(C.ws + WS_SLOT); const size_t ro = (size_t)h * HS128 + (size_t)qb * 256 * 128;
    r.P0 = qb * 256; r.sel = nullptr; r.stats = nullptr;
    if (!cmp) {
        r.Q = (const fa::bf16*)((const bf16_t*)(C.ws + WS_QROT) + ro); r.K = (const fa::bf16*)(slot + (size_t)(32 + hk) * HS128); r.V = (const fa::bf16*)(slot + (size_t)(36 + hk) * HS128);
        r.O = (fa::bf16*)((bf16_t*)(C.ws + WS_OW) + ro); r.W = 512; const int lowk = r.P0 - 511; r.jlo = lowk > 0 ? lowk / 64 : 0; r.jhi = 4 * qb + 4; r.psub = 0; r.psh = 0;
    } else {
        r.Q = (const fa::bf16*)(slot + ro); r.K = (const fa::bf16*)((const bf16_t*)(C.ws + WS_KC2) + (size_t)hk * 512 * 128); r.V = (const fa::bf16*)((const bf16_t*)(C.ws + WS_KC2) + (size_t)2048 * 128 + (size_t)hk * 512 * 128);
        r.O = (fa::bf16*)((bf16_t*)(C.ws + WS_OC) + ro); r.W = W_CAUSAL; r.jlo = 0; r.jhi = (((r.P0 + 224) >> 4) >> 6) + 1; r.psub = 31; r.psh = 4;
        r.stats = (float2*)(C.ws + WS_STATS) + (size_t)h * S + qb * 256;
    }
    return true;
}
__device__ __forceinline__ bool refS(const Ctx& C, int q, RefB& r) {
    const int pair = C.bid + (q >> 1) * C.G; if (pair >= 256) return false;
    const int h = pair >> 4, p = pair & 15, qb = (q & 1) ? 31 - p : p, hk = h >> 2;
    const bf16_t* slot = (const bf16_t*)(C.ws + WS_SLOT); const size_t ro = (size_t)h * HS128 + (size_t)qb * 256 * 128;
    r.P0 = qb * 256; r.stats = nullptr; r.sel = (const fa::u32x4*)(C.ws + WS_MASK) + (size_t)hk * S + qb * 256;
    r.Q = (const fa::bf16*)((const bf16_t*)(C.ws + WS_QROT) + ro); r.K = (const fa::bf16*)(slot + (size_t)(24 + hk) * HS128); r.V = (const fa::bf16*)(slot + (size_t)(28 + hk) * HS128);
    r.O = (fa::bf16*)((bf16_t*)(C.ws + WS_OS) + ro); r.W = W_CAUSAL; r.jlo = 0; r.jhi = 4 * qb + 4; r.psub = 0; r.psh = 0;
    return true;
}
__device__ __forceinline__ bool refD(const Ctx& C, int q, RefF& r) {
    const int pair = C.bid + (q >> 1) * C.G; if (pair >= 512) return false;
    const int inst = pair >> 4, p = pair & 15, qb = (q & 1) ? 31 - p : p, hk = inst >> 3, c = inst & 1;
    const size_t ro = (size_t)inst * HS128 + (size_t)qb * 256 * 128;
    r.P0 = qb * 256; r.stats = nullptr; r.sel = nullptr;
    r.Q = (const fa::bf16*)((const bf16_t*)(C.ws + WS_QD) + ro); r.K = (const fa::bf16*)((const bf16_t*)(C.ws + WS_KD) + (size_t)(hk * 2 + c) * HS128); r.V = (const fa::bf16*)((const bf16_t*)(C.ws + WS_VD) + (size_t)hk * HS128);
    r.O = (float*)(C.ws + WS_OD) + ro; r.W = W_CAUSAL; r.jlo = 0; r.jhi = 4 * qb + 4; r.psub = 0; r.psh = 0;
    return true;
}
#define FLASH_STREAM(REFT, TOUT, HSEL, MK, NDV) do { struct NF_ { const Ctx& C; int q; __device__ __forceinline__ REFT operator()(const REFT& cur) const { REFT r; if (!MK(C, q, r)) r = cur; return r; } }; \
        REFT cur_; int q_ = 0; if (MK(C, 0, cur_)) { fa::Seam<fa::bf16> Sm = {}; fa::causal_swa_prime<fa::bf16, TOUT>(cur_, C.lds, Sm, C.tid); \
        for (;;) { const NF_ nf_{C, q_ + 1}; fa::causal_swa_block<fa::bf16, TOUT, HSEL, NF_, NDV>(cur_, nf_, C.lds, Sm, C.tid); REFT nxt_; if (!MK(C, q_ + 1, nxt_)) break; cur_ = nxt_; ++q_; } } } while (0)

__device__ __forceinline__ u32x4 select_blocks(const LAS float* ip, int cur, int lane) {
    unsigned w0 = 0u, w1 = 0u, w2 = 0u, w3 = 0u;
    if (cur <= 15) { w0 = (1u << (cur + 1)) - 1u; }
    else {
        const float v0 = fmaxf(ip[lane], 0.f), v1 = fmaxf(ip[lane + 64], 0.f);
        const int hi = cur - 2;
        const unsigned k0 = (lane >= 1 && lane <= hi) ? ((__float_as_uint(v0) & ~127u) | (unsigned)(127 - lane)) : 0u;
        const unsigned k1 = (lane + 64 <= hi) ? ((__float_as_uint(v1) & ~127u) | (unsigned)(63 - lane)) : 0u;
        unsigned T = 0u;
#pragma unroll 4
        for (int b = 30; b >= 0; --b) { const unsigned cand = T | (1u << b); const int cnt = __popcll(__ballot(k0 >= cand)) + __popcll(__ballot(k1 >= cand)); if (cnt >= 13) T = cand; }
        const unsigned long long m0 = __ballot(k0 != 0u && k0 >= T), m1 = __ballot(k1 != 0u && k1 >= T);
        w0 = (unsigned)m0; w1 = (unsigned)(m0 >> 32); w2 = (unsigned)m1; w3 = (unsigned)(m1 >> 32);
        w0 |= 1u;
#pragma unroll
        for (int e = 0; e < 2; ++e) { const int s = cur - e; const unsigned bit = 1u << (s & 31); const int sw = s >> 5;
            if (sw == 0) w0 |= bit; else if (sw == 1) w1 |= bit; else if (sw == 2) w2 |= bit; else w3 |= bit; }
    }
    return (u32x4){w0, w1, w2, w3};
}
__device__ __forceinline__ void imp_unit(const Ctx& C, int hk, int tb) {
    u32x4* maskp = (u32x4*)(C.ws + WS_MASK) + (size_t)hk * S + tb * 64;
    if (tb < 16) { if (C.lane < 8) maskp[C.wave * 8 + C.lane] = (u32x4){(1u << (tb + 1)) - 1u, 0u, 0u, 0u}; return; }
    const int w = C.wave, g = w >> 1, th = w & 1, lane = C.lane, r32 = lane & 31, hi = lane >> 5, h = hk * 4 + g;
    const int token = tb * 64 + th * 32 + r32;
    const bf16_t* Q = (const bf16_t*)(C.ws + WS_SLOT) + (size_t)h * HS128 + (size_t)token * 128;
    const bf16_t* Kc = (const bf16_t*)(C.ws + WS_KC2) + (size_t)hk * 512 * 128;
    bf16x8 qr[8];
#pragma unroll
    for (int d0 = 0; d0 < 8; ++d0) qr[d0] = *(const bf16x8*)(Q + d0 * 16 + hi * 8);
    const float2 st = ((const float2*)(C.ws + WS_STATS))[(size_t)h * S + token];
    constexpr float C2 = 1.4426950408889634f * fa::SCALE;
    const float mC2 = -st.x * C2, il = 1.0f / st.y;
    char* K_lds = C.lds; LAS float* red = (LAS float*)(C.lds + 16384);
    const int NT = ((4 * (tb - 2) + 3) >> 6) + 1;
    const int sr = C.tid >> 4, sc = (C.tid & 15) * 8, kws = KSWZ(sr, sc * 2);
    float carry = 0.f;
    LAS float* impl = (LAS float*)(C.lds + 32768);
    LAS float* impo = impl + (th * 32 + r32) * 128;
    bf16x8 kn0 = *(const bf16x8*)(Kc + (size_t)sr * 128 + sc), kn1 = *(const bf16x8*)(Kc + (size_t)(32 + sr) * 128 + sc);
    for (int t = 0; t < NT; ++t) {
        *(bf16x8*)(K_lds + kws) = kn0; *(bf16x8*)(K_lds + kws + 32 * 256) = kn1;
        if (t + 1 < NT) { kn0 = *(const bf16x8*)(Kc + (size_t)((t + 1) * 64 + sr) * 128 + sc); kn1 = *(const bf16x8*)(Kc + (size_t)((t + 1) * 64 + 32 + sr) * 128 + sc); }
        __syncthreads();
        f32x16 p0, p1;
        fa::qkt<0, false>(p0, p1, K_lds, r32, hi, qr, true);
#pragma unroll
        for (int r = 0; r < 16; ++r) { p0[r] = __builtin_amdgcn_exp2f(fmaf(p0[r], C2, mC2)) * il; p1[r] = __builtin_amdgcn_exp2f(fmaf(p1[r], C2, mC2)) * il; }
        float gs[2][4], ot[2][4];
#pragma unroll
        for (int a = 0; a < 4; ++a) { gs[0][a] = (p0[4 * a] + p0[4 * a + 1]) + (p0[4 * a + 2] + p0[4 * a + 3]); gs[1][a] = (p1[4 * a] + p1[4 * a + 1]) + (p1[4 * a + 2] + p1[4 * a + 3]);
            ot[0][a] = __shfl_xor(p0[4 * a + 3], 32); ot[1][a] = __shfl_xor(p1[4 * a + 3], 32); }
        float iv[2][4];
#pragma unroll
        for (int H = 0; H < 2; ++H)
#pragma unroll
            for (int a = 0; a < 4; ++a) { float prev; if (hi) prev = ot[H][a]; else prev = a > 0 ? ot[H][a - 1] : (H == 1 ? ot[0][3] : carry); iv[H][a] = gs[H][a] + prev; }
        carry = ot[1][3];
        { LAS f32x4* rp = (LAS f32x4*)(red + ((g * 2 + th) * 64 + lane) * 8); rp[0] = (f32x4){iv[0][0], iv[0][1], iv[0][2], iv[0][3]}; rp[1] = (f32x4){iv[1][0], iv[1][1], iv[1][2], iv[1][3]}; }
        __syncthreads();
        if (g == 0) {
            f32x4 a0 = {0.f, 0.f, 0.f, 0.f}, a1 = a0;
#pragma unroll
            for (int gg = 0; gg < 4; ++gg) { const LAS f32x4* rp = (const LAS f32x4*)(red + ((gg * 2 + th) * 64 + lane) * 8); a0 = a0 + rp[0]; a1 = a1 + rp[1]; }
#pragma unroll
            for (int a = 0; a < 4; ++a) { impo[16 * t + 2 * a + hi] = a0[a]; impo[16 * t + 8 + 2 * a + hi] = a1[a]; }
        }
    }
    __syncthreads();
    for (int j = 0; j < 8; ++j) { const int tt = C.wave * 8 + j; const u32x4 m = select_blocks(impl + tt * 128, tb, C.lane); if (C.lane == 0) maskp[tt] = m; }
    __syncthreads();
}
__device__ __forceinline__ void imp_phase(const Ctx& C) {
    for (int pair = C.bid; pair < 256; pair += C.G) { const int hk = pair >> 6, p = pair & 63; imp_unit(C, hk, p); imp_unit(C, hk, 127 - p); }
}
__device__ __forceinline__ void topk_phase(const Ctx& C) {
    const float* imp = (const float*)(C.ws + WS_IMP); u32x4* mask = (u32x4*)(C.ws + WS_MASK);
    for (int item0 = C.gw; item0 < 4 * S; item0 += 4 * C.NGW) {
      float pv0[4], pv1[4];
#pragma unroll
      for (int u = 0; u < 4; ++u) { const int it_ = item0 + u * C.NGW; const float* ip = imp + (size_t)(it_ < 4 * S ? it_ : item0) * 128; pv0[u] = ip[C.lane]; pv1[u] = ip[C.lane + 64]; }
#pragma unroll
      for (int u = 0; u < 4; ++u) { const int item = item0 + u * C.NGW; if (item >= 4 * S) break;
        const int token = item & (S - 1), cur = token >> 6, lane = C.lane;
        unsigned w0 = 0u, w1 = 0u, w2 = 0u, w3 = 0u;
        if (cur <= 15) { w0 = (1u << (cur + 1)) - 1u; }
        else {
            const float v0 = fmaxf(pv0[u], 0.f), v1 = fmaxf(pv1[u], 0.f);
            const int hi = cur - 2;
            const unsigned k0 = (lane >= 1 && lane <= hi) ? ((__float_as_uint(v0) & ~127u) | (unsigned)(127 - lane)) : 0u;
            const unsigned k1 = (lane + 64 <= hi) ? ((__float_as_uint(v1) & ~127u) | (unsigned)(63 - lane)) : 0u;
            unsigned T = 0u;
#pragma unroll 4
            for (int b = 30; b >= 0; --b) { const unsigned cand = T | (1u << b); const int cnt = __popcll(__ballot(k0 >= cand)) + __popcll(__ballot(k1 >= cand)); if (cnt >= 13) T = cand; }
            const unsigned long long m0 = __ballot(k0 != 0u && k0 >= T), m1 = __ballot(k1 != 0u && k1 >= T);
            w0 = (unsigned)m0; w1 = (unsigned)(m0 >> 32); w2 = (unsigned)m1; w3 = (unsigned)(m1 >> 32);
            w0 |= 1u;
#pragma unroll
            for (int e = 0; e < 2; ++e) { const int s = cur - e; const unsigned bit = 1u << (s & 31); const int sw = s >> 5;
                if (sw == 0) w0 |= bit; else if (sw == 1) w1 |= bit; else if (sw == 2) w2 |= bit; else w3 |= bit; }
        }
        if (lane == 0) mask[item] = (u32x4){w0, w1, w2, w3};
      }
    }
}
__device__ __forceinline__ void combine_nsa(const Ctx& C) {
    const bf16_t* OC = (const bf16_t*)(C.ws + WS_OC); const bf16_t* OS = (const bf16_t*)(C.ws + WS_OS); const bf16_t* OW = (const bf16_t*)(C.ws + WS_OW);
    const float* gates = (const float*)(C.ws + WS_GATES); bf16_t* O = (bf16_t*)(C.ws + WS_O);
    const int lg = C.lane >> 4, d = (C.lane & 15) * 8;
    for (int it4 = C.gw; it4 < S * 16 / 4; it4 += 2 * C.NGW) {
        u32x4 a[2], b[2], c[2]; float g0[2], g1[2], g2[2]; int tok[2], hh[2];
#pragma unroll
        for (int u = 0; u < 2; ++u) { int it = it4 + u * C.NGW; if (it >= S * 16 / 4) it = it4; const int item = it * 4 + lg; tok[u] = item >> 4; hh[u] = item & 15;
            g0[u] = gates[(size_t)tok[u] * 48 + hh[u] * 3]; g1[u] = gates[(size_t)tok[u] * 48 + hh[u] * 3 + 1]; g2[u] = gates[(size_t)tok[u] * 48 + hh[u] * 3 + 2];
            const size_t off = (size_t)hh[u] * HS128 + (size_t)tok[u] * 128 + d; a[u] = *(const u32x4*)(OC + off); b[u] = *(const u32x4*)(OS + off); c[u] = *(const u32x4*)(OW + off); }
#pragma unroll
        for (int u = 0; u < 2; ++u) { if (u == 1 && it4 + C.NGW >= S * 16 / 4) break;
            u32x4 o;
#pragma unroll
            for (int j = 0; j < 4; ++j) { const unsigned ua = a[u][j], ub = b[u][j], uc = c[u][j];
                const float lo = g0[u] * __uint_as_float(ua << 16) + g1[u] * __uint_as_float(ub << 16) + g2[u] * __uint_as_float(uc << 16);
                const float hv = g0[u] * __uint_as_float(ua & 0xffff0000u) + g1[u] * __uint_as_float(ub & 0xffff0000u) + g2[u] * __uint_as_float(uc & 0xffff0000u);
                o[j] = pk2(lo, hv); }
            *(u32x4*)(O + (size_t)tok[u] * DM + hh[u] * 128 + d) = o; }
    }
}
__device__ __forceinline__ void combine_diff(const Ctx& C, KParamsPtr prm, int jl) {
    const float* lv = prm->in[12] + (size_t)jl * 4 * 64; const float* sg = prm->in[13] + (size_t)jl * 128;
    const float linit = jl == 0 ? 0.47071301834358416f : 0.5560582041556405f;
    const float d1 = wave_sum(lv[C.lane] * lv[64 + C.lane]), d2 = wave_sum(lv[128 + C.lane] * lv[192 + C.lane]);
    const float lam = expf(d1) - expf(d2) + linit;
    const float* OD = (const float*)(C.ws + WS_OD); bf16_t* O = (bf16_t*)(C.ws + WS_O);
    const int lg = C.lane >> 4, d = (C.lane & 15) * 8;
    const f32x4 ga = *(const f32x4*)(sg + d), gb = *(const f32x4*)(sg + d + 4);
    for (int it4 = C.gw; it4 < S * 16 / 4; it4 += C.NGW) {
        const int item = it4 * 4 + lg, token = item >> 4, h = item & 15;
        const size_t o1 = (size_t)(h * 2) * HS128 + (size_t)token * 128 + d, o2 = o1 + HS128;
        f32x4 a0 = *(const f32x4*)(OD + o1), a1 = *(const f32x4*)(OD + o1 + 4); const f32x4 b0 = *(const f32x4*)(OD + o2), b1 = *(const f32x4*)(OD + o2 + 4);
        a0 = a0 - b0 * lam; a1 = a1 - b1 * lam;
        float ss = (a0.x * a0.x + a0.y * a0.y) + (a0.z * a0.z + a0.w * a0.w) + (a1.x * a1.x + a1.y * a1.y) + (a1.z * a1.z + a1.w * a1.w);
        ss += __shfl_xor(ss, 1); ss += __shfl_xor(ss, 2); ss += __shfl_xor(ss, 4); ss += __shfl_xor(ss, 8);
        const float r = (1.0f / sqrtf(ss * (1.0f / 128.0f) + 1e-6f)) * (1.0f - linit);
        a0 = a0 * r * ga; a1 = a1 * r * gb;
        u32x4 o; o.x = pk2(a0.x, a0.y); o.y = pk2(a0.z, a0.w); o.z = pk2(a1.x, a1.y); o.w = pk2(a1.z, a1.w);
        *(u32x4*)(O + (size_t)token * DM + h * 128 + d) = o;
    }
}
__device__ __forceinline__ void prologue(const Ctx& C, KParamsPtr prm) {
    bf16_t* Wb = (bf16_t*)(C.ws + WS_W); int cbase = 0;
    const float* attn_g = prm->in[1]; const float* mlp_g = prm->in[2];
    for (int l = 3; l >= 0; --l) {
        conv_matrix(C, prm->in[16] + (size_t)l * FF * DM, FF, DM, DM, DM, nullptr, Wb + WOFF_DN + (size_t)l * FF * DM, FF, cbase);
        conv_matrix(C, prm->in[15] + (size_t)l * DM * FF, DM, FF, FF, FF, mlp_g + l * DM, Wb + WOFF_UP + (size_t)l * FF * DM, DM, cbase);
    }
    for (int j = 1; j >= 0; --j) conv_matrix(C, prm->in[14] + (size_t)j * DM * DM, DM, DM, DM, DM, nullptr, Wb + WOFF_DWO + (size_t)j * DM * DM, DM, cbase);
    conv_matrix(C, prm->in[11] + (size_t)DM * DM, DM, DM, DM, DM, attn_g + 3 * DM, Wb + WOFF_Q3, DM, cbase);
    conv_matrix(C, prm->in[10], DM, 1024, 1024, 1024, prm->in[9], Wb + WOFF_QKV + (size_t)DM * DM, DM, cbase);
    conv_matrix(C, prm->in[11], DM, DM, DM, DM, attn_g + 2 * DM, Wb + WOFF_QKV, DM, cbase);
    for (int l = 1; l >= 0; --l) {
        bf16_t* base = Wb + WOFF_NSA + (size_t)l * W_NSA_SZ;
        conv_matrix(C, prm->in[8] + (size_t)l * DM * DM, DM, DM, DM, DM, nullptr, base + W_IN_SZ + W_C_SZ + W_2_SZ, DM, cbase);
        for (int j = 0; j < 2; ++j) conv_matrix(C, prm->in[7] + (size_t)(l * 2 + j) * 512 * 128, 512, 128, 128, 128, nullptr, base + W_IN_SZ + W_C_SZ + (size_t)j * 128 * 512, 512, cbase);
        for (int j = 0; j < 2; ++j) for (int hf = 0; hf < 2; ++hf)
            conv_matrix(C, prm->in[6] + ((size_t)(l * 2 + j) * 4096 + (size_t)hf * 2048) * 512, 2048, 512, 512, 512, nullptr, base + W_IN_SZ + ((size_t)j * 1024 + (size_t)hf * 512) * 2048, 2048, cbase);
        conv_matrix(C, prm->in[4] + (size_t)l * DM * NIN, DM, NIN, NINP, NIN, attn_g + l * DM, base, DM, cbase);
    }
    { float* cosA = (float*)(C.ws + WS_TAB + TAB_COSA); float* sinA = (float*)(C.ws + WS_TAB + TAB_SINA); float* cosB = (float*)(C.ws + WS_TAB + TAB_COSB); float* sinB = (float*)(C.ws + WS_TAB + TAB_SINB);
      const int gt = C.bid * 512 + C.tid, NT = C.G * 512;
      for (int idx = gt; idx < S * 16; idx += NT) { const int pos = idx >> 4, i = idx & 15; const float inv = 1.0f / powf(500000.0f, (float)(2 * i) / 32.0f); const float ang = (float)pos * inv;
          float sn, cs; sincosf(ang, &sn, &cs); cosA[idx] = cs; sinA[idx] = sn; if ((i & 1) == 0) { cosB[pos * 8 + (i >> 1)] = cs; sinB[pos * 8 + (i >> 1)] = sn; } } }
    __syncthreads();
    { float* biasp = (float*)(C.ws + WS_TAB + TAB_BIASP); LAS float* red = (LAS float*)C.lds;
      for (int u = C.bid; u < 256; u += C.G) { const int lj = u >> 6, kc = (u >> 3) & 7, cgp = u & 7, c = cgp * 64 + C.lane;
          const float* pos = prm->in[5] + (size_t)lj * 4096 + kc * 512 + C.wave * 64; const float* w1 = prm->in[6] + ((size_t)lj * 4096 + kc * 512 + C.wave * 64) * 512 + c;
          float v[64];
#pragma unroll
          for (int k = 0; k < 64; ++k) v[k] = w1[(size_t)k * 512];
          float a = 0.f;
#pragma unroll
          for (int k = 0; k < 64; ++k) a = fmaf(pos[k], v[k], a);
          red[C.wave * 64 + C.lane] = a;
          __syncthreads();
          if (C.wave == 0) { float t = 0.f;
#pragma unroll
              for (int w = 0; w < 8; ++w) t += red[w * 64 + C.lane];
              biasp[((size_t)lj * 8 + kc) * 512 + c] = t; }
          __syncthreads(); } }
    xb_phase(C, prm->in[0], (bf16_t*)(C.ws + WS_XN), (float*)(C.ws + WS_ROWSS));
}

#ifndef EN_G1
#define EN_G1 1
#endif
#ifndef EN_G2
#define EN_G2 1
#endif
#ifndef EN_G3
#define EN_G3 1
#endif
#ifndef EN_G4
#define EN_G4 1
#endif
#ifndef EN_G5
#define EN_G5 1
#endif
#ifndef EN_G6
#define EN_G6 1
#endif
#ifndef EN_G7
#define EN_G7 1
#endif
#ifndef EN_FA
#define EN_FA 1
#endif
#ifndef EN_FS
#define EN_FS 1
#endif
#ifndef EN_FD
#define EN_FD 1
#endif
#ifndef EN_GEMM
#define EN_GEMM 1
#endif
#ifndef EN_IMP
#define EN_IMP 1
#endif
#ifndef EN_PRO
#define EN_PRO 1
#endif

#ifdef TEST_MIN
__global__ void __launch_bounds__(512, 2) test_min(Params prm) {
    extern __shared__ __attribute__((aligned(16))) unsigned char lds_raw2[];
    LAS unsigned char* glds = (LAS unsigned char*)lds_raw2;
    bf16_t* Wb = (bf16_t*)(prm.ws + WS_W); float* X = (float*)(prm.ws + WS_X); bf16_t* Obuf = (bf16_t*)(prm.ws + WS_O);
#if TEST_MIN == 1
    pg8::Gemm g{Obuf, Wb, S, DM, DM, DM, DM}; pg8::StaticOrder So; So.init(S, DM, gridDim.x, blockIdx.x);
    EpiRes E{X}; pg8::gemm_phase<EpiRes, pg8::StaticOrder, true, true>(glds, g, So, E, C.tid);
#elif TEST_MIN == 2
    pg8::Gemm g{Obuf, Wb, S, DM, DM, DM, DM}; pg8::StaticOrder So; So.init(S, DM, gridDim.x, blockIdx.x);
    EpiUp E{Obuf}; pg8::gemm_phase<EpiUp, pg8::StaticOrder, true, true>(glds, g, So, E, C.tid);
#endif
}
#endif
enum { K_PRO = 0, K_WIN, K_CMP1, K_CMP2, K_FA, K_IMP, K_TOPK, K_FS, K_COMBN, K_RES, K_NORM, K_UP, K_QPROJ, K_FD, K_COMBD };
__global__ void __launch_bounds__(512, 2) yoco_fwd(Params prm) {
    extern __shared__ __attribute__((aligned(16))) unsigned char lds_raw[];
    cg::grid_group grid = cg::this_grid();
    const int lo = prm.ph_lo, hi = prm.ph_hi;
    const int wave_s = __builtin_amdgcn_readfirstlane((int)threadIdx.x >> 6);
    if (threadIdx.x < 64) ((volatile LAS unsigned*)(lds_raw + 131072))[threadIdx.x] = 0u;
    if (blockIdx.x == 0) { for (int i = threadIdx.x; i < XCD_BAR_WORDS; i += 512) ((unsigned*)prm.ws)[i] = 0u; }
    __syncthreads();
    XcdBarrier bar; bar.bar = (unsigned*)prm.ws; bar.x = 0; bar.st = nullptr;
    bool rep_done = false, bar_ready = false;
    for (int ph = lo; ph < hi; ++ph) {
        int l = 0, kind = K_PRO; bool is_down = false;
        if (ph >= 33) { kind = K_NORM; l = 3; }
        else if (ph >= 21) { const int r = ph - 21; l = 2 + r / 6; const int sub = r % 6; is_down = sub == 5;
            kind = sub == 0 ? K_QPROJ : sub == 1 ? K_FD : sub == 2 ? K_COMBD : sub == 3 ? K_RES : sub == 4 ? K_UP : K_RES; }
        else if (ph >= 1) { const int r = ph - 1; l = r / 10; const int sub = r % 10; is_down = sub == 9;
            kind = sub == 0 ? K_WIN : sub == 1 ? K_CMP1 : sub == 2 ? K_CMP2 : sub == 3 ? K_FA : sub == 4 ? K_IMP : sub == 5 ? K_FS : sub == 6 ? K_COMBN : sub == 7 ? K_RES : sub == 8 ? K_UP : K_RES; }
#define MKCTX const KParamsPtr kp_ = lprm(); Ctx C; C.ws = kp_->ws; C.lds = (char*)lds_raw; C.tid = mktid(wave_s); C.lane = C.tid & 63; C.wave = __builtin_amdgcn_readfirstlane(C.tid >> 6); C.G = lgrid(); C.bid = lbid(); C.gw = C.bid * 8 + C.wave; C.NGW = C.G * 8; \
        LAS unsigned char* glds = (LAS unsigned char*)lds_raw; bf16_t* Wb = (bf16_t*)(C.ws + WS_W); float* X = (float*)(C.ws + WS_X); bf16_t* XN = (bf16_t*)(C.ws + WS_XN); bf16_t* Obuf = (bf16_t*)(C.ws + WS_O); bf16_t* U = (bf16_t*)(C.ws + WS_U); \
        bf16_t* wl = Wb + WOFF_NSA + (size_t)(l & 1) * W_NSA_SZ; const int jl = l - 2; (void)glds; (void)X; (void)XN; (void)Obuf; (void)U; (void)wl; (void)jl;
        switch (kind) {
        case K_PRO: { MKCTX prologue(C, kp_); } break;
        case K_WIN: { MKCTX
            pg8::Gemm g{XN, wl, S, NINP, DM, DM, DM}; pg8::StaticOrder So; So.init(S, NINP, C.G, C.bid);
            EpiIn E{(bf16_t*)(C.ws + WS_SLOT), (bf16_t*)(C.ws + WS_QROT), (float*)(C.ws + WS_GATES), (const float*)(C.ws + WS_TAB + TAB_COSA), (const float*)(C.ws + WS_TAB + TAB_SINA), (const LAS float*)(C.lds + LDS_RSTD)};
            rstd_prestep(C, So, (const float*)(C.ws + WS_ROWSS));
            pg8::gemm_phase<EpiIn, pg8::StaticOrder, true, true>(glds, g, So, E, C.tid); } break;
        case K_CMP1: { MKCTX
            pg8::Gemm g{(const bf16_t*)(C.ws + WS_SLOT) + 16 * HS128, wl + W_IN_SZ, 2048, 1024, 512, 2048, 2048};
            ZSched Z{8, 4, 8, C.G, C.bid, (size_t)4 * HS128 * 2, (size_t)512 * 2, (size_t)1024 * 2048 * 2, (size_t)512 * 2};
            EpiPart E{(float*)(C.ws + WS_PART)};
            pg8::gemm_phase<EpiPart, ZSched, true, true>(glds, g, Z, E, C.tid); } break;
        case K_CMP2: { MKCTX cmp2_phase(C, (const float*)(C.ws + WS_PART), (const float*)(C.ws + WS_TAB + TAB_BIASP) + (size_t)l * 2 * 8 * 512, wl + W_IN_SZ + W_C_SZ, (bf16_t*)(C.ws + WS_KC2)); } break;
        case K_FA: { MKCTX FLASH_STREAM(RefB, fa::bf16, false, refA, 8); } break;
        case K_IMP: { MKCTX imp_phase(C); } break;
        case K_TOPK: { MKCTX topk_phase(C); } break;
        case K_FS: { MKCTX FLASH_STREAM(RefB, fa::bf16, true, refS, 8); } break;
        case K_COMBN: { MKCTX combine_nsa(C); } break;
        case K_RES: { MKCTX
            const bf16_t* Wt = is_down ? Wb + WOFF_DN + (size_t)l * FF * DM : (l < 2 ? wl + W_IN_SZ + W_C_SZ + W_2_SZ : Wb + WOFF_DWO + (size_t)jl * DM * DM);
            const int K = is_down ? FF : DM;
            pg8::Gemm g{is_down ? U : Obuf, Wt, S, DM, K, K, K}; pg8::StaticOrder So; So.init(S, DM, C.G, C.bid);
            EpiRes E{(l == 0 && !is_down) ? kp_->in[0] : (const float*)nullptr, XN, (float*)(C.ws + WS_ROWSS)}; pg8::gemm_phase<EpiRes, pg8::StaticOrder, true, true>(glds, g, So, E, C.tid); } break;
        case K_NORM: { MKCTX final_norm_phase(C, XN, kp_->out, kp_->in[3]); } break;
        case K_UP: { MKCTX
            pg8::Gemm g{XN, Wb + WOFF_UP + (size_t)l * FF * DM, S, FF, DM, DM, DM}; pg8::StaticOrder So; So.init(S, FF, C.G, C.bid);
            EpiUp E{U, (const LAS float*)(C.lds + LDS_RSTD)}; rstd_prestep(C, So, (const float*)(C.ws + WS_ROWSS)); pg8::gemm_phase<EpiUp, pg8::StaticOrder, true, true>(glds, g, So, E, C.tid); } break;
        case K_QPROJ: { MKCTX
            const int N = jl == 0 ? 3072 : 2048;
            pg8::Gemm g{XN, jl == 0 ? Wb + WOFF_QKV : Wb + WOFF_Q3, S, N, DM, DM, DM}; pg8::StaticOrder So; So.init(S, N, C.G, C.bid);
            EpiQ E{(bf16_t*)(C.ws + WS_QD), (bf16_t*)(C.ws + WS_KD), (bf16_t*)(C.ws + WS_VD), (const float*)(C.ws + WS_TAB + TAB_COSB), (const float*)(C.ws + WS_TAB + TAB_SINB), (const LAS float*)(C.lds + LDS_RSTD)};
            rstd_prestep(C, So, (const float*)(C.ws + WS_ROWSS));
            pg8::gemm_phase<EpiQ, pg8::StaticOrder, true, true>(glds, g, So, E, C.tid); } break;
        case K_FD: { MKCTX FLASH_STREAM(RefF, float, false, refD, 4); } break;
        case K_COMBD: { MKCTX combine_diff(C, kp_, jl); } break;
        default: break;
        }
        if (ph + 1 < hi) {
            const bool t0_ = mktid(wave_s) == 0;
            if (!bar_ready) { bar_ready = true; grid.sync(); bar = xcd_barrier_post(bar.bar, (volatile LAS unsigned*)(lds_raw + 131072), t0_); }
            else { xcd_barrier(bar, t0_); if (PROBE == 1) xcd_barrier(bar, t0_); }
        }
        if (PROBE >= 2) { if (kind == PROBE - 2 && !rep_done) { rep_done = true; --ph; } else rep_done = false; }
    }
}
constexpr int N_PHASES = 1 + 2 * 10 + 2 * 6 + 1;

#ifndef MK_MULTI
#define MK_MULTI 0
#endif
extern "C" void kernel_launch(void* const* d_in, const int* in_sizes, int n_in, void* d_out, int out_size, void* d_ws, size_t ws_size, hipStream_t stream) {
    static int grid = 0;
    if (grid == 0) {
        if (n_in != 17 || ws_size < WS_END) { fprintf(stderr, "kernel_launch: unexpected n_in %d / ws_size %zu (need %zu)\n", n_in, ws_size, (size_t)WS_END); grid = -1; return; }
        int dev = 0, cus = 0, per_cu = 0;
        (void)hipGetDevice(&dev); (void)hipDeviceGetAttribute(&cus, hipDeviceAttributeMultiprocessorCount, dev);
        if (hipFuncSetAttribute((const void*)yoco_fwd, hipFuncAttributeMaxDynamicSharedMemorySize, LDS_BYTES) != hipSuccess) { fprintf(stderr, "kernel_launch: hipFuncSetAttribute failed\n"); }
        if (hipOccupancyMaxActiveBlocksPerMultiprocessor(&per_cu, (const void*)yoco_fwd, 512, LDS_BYTES) != hipSuccess || per_cu < 1) { fprintf(stderr, "kernel_launch: occupancy query gave %d\n", per_cu); per_cu = 1; }
        (void)hipGetLastError();
        if (cus <= 0) cus = 256;
        grid = cus;
    }
    if (grid < 0) return;
    Params p{};
    for (int i = 0; i < 17; ++i) p.in[i] = (const float*)d_in[i];
    p.out = (float*)d_out; p.ws = (unsigned char*)d_ws;
#if MK_MULTI
    for (int ph = 0; ph < N_PHASES; ++ph) { p.ph_lo = ph; p.ph_hi = ph + 1; hipLaunchKernelGGL(yoco_fwd, dim3(grid), dim3(512), LDS_BYTES, stream, p); }
#else
    p.ph_lo = 0; p.ph_hi = N_PHASES;
    void* args[] = {&p};
    hipError_t e = hipLaunchCooperativeKernel((const void*)yoco_fwd, dim3(grid), dim3(512), args, LDS_BYTES, stream);
    if (e != hipSuccess) fprintf(stderr, "cooperative launch failed: %s (grid %d)\n", hipGetErrorString(e), grid);
#endif
}
```
